# Optimizing an MI355X kernel written in HIP

```python
import math
import jax, jax.numpy as jnp
from jax import lax
import numpy as np

D_MODEL = 1024
BATCH = 8
SEQ = 4096
DEPTH = 1

CHUNK = 64
N_META = 16
POOL_WINDOWS = (2, 4, 8, 16)
POOL_GROUPS = len(POOL_WINDOWS)
D_POOL = D_MODEL // 2
POOL_GW = D_POOL // POOL_GROUPS
N_HEADS = 8
QK_NOPE = 64
QK_ROPE = 32
V_DIM = 64
Q_LORA = 384
KV_LORA = 256
ROPE_THETA = 10000.0
Q_BLOCK = 128
ATTN_SCALE = (QK_NOPE + QK_ROPE) ** -0.5
N_BRANCH = 2
D_FF = 2816
CONV_W = 3
EPS = 1e-6
ALPHA = (2.0 * DEPTH) ** 0.25
BETA = (8.0 * DEPTH) ** -0.25
SPLIT_SIZES = (D_POOL, Q_LORA, KV_LORA, QK_ROPE, N_BRANCH * D_MODEL)
D_IN = sum(SPLIT_SIZES)
SPLIT_POINTS = tuple(int(v) for v in np.cumsum(SPLIT_SIZES)[:-1])

kernel_name = "hybrid_pool_mla_gated_convffn_deepnorm"


def layer_norm(x, g, b):
    xf = x.astype(jnp.float32)
    mu = jnp.mean(xf, axis=-1, keepdims=True)
    var = jnp.mean(jnp.square(xf - mu), axis=-1, keepdims=True)
    return ((xf - mu) * lax.rsqrt(var + EPS)).astype(x.dtype) * g + b


def rms_norm(x, g):
    xf = x.astype(jnp.float32)
    ms = jnp.mean(jnp.square(xf), axis=-1, keepdims=True)
    return (xf * lax.rsqrt(ms + EPS)).astype(x.dtype) * g


def rope_tables(L, dtype):
    pos = jnp.arange(L, dtype=jnp.float32)
    inv = ROPE_THETA ** (-jnp.arange(0, QK_ROPE, 2, dtype=jnp.float32) / QK_ROPE)
    ang = pos[:, None] * inv[None, :]
    return jnp.cos(ang).astype(dtype), jnp.sin(ang).astype(dtype)


def apply_rope(x, cos, sin):
    x1, x2 = jnp.split(x, 2, axis=-1)
    return jnp.concatenate([x1 * cos - x2 * sin, x2 * cos + x1 * sin], axis=-1)


def multiscale_pool(v, pool_w, pool_scale):
    B, L, _ = v.shape
    vg = v.reshape(B, L, POOL_GROUPS, POOL_GW)
    cs = jnp.cumsum(vg.astype(jnp.float32), axis=1)
    cs0 = jnp.concatenate([jnp.zeros_like(cs[:, :1]), cs], axis=1)
    t = jnp.arange(L)
    means = []
    for g, w in enumerate(POOL_WINDOWS):
        upper = cs0[:, 1:, g]
        lower = cs0[:, jnp.maximum(t + 1 - w, 0), g]
        cnt = jnp.minimum(t + 1, w).astype(jnp.float32)[None, :, None]
        means.append((upper - lower) / cnt)
    mean = jnp.stack(means, axis=2).astype(v.dtype)
    y = jnp.einsum('blgc,gcd->blgd', mean - vg, pool_w)
    return y.reshape(B, L, D_POOL) * pool_scale


def key_extent(q_last, L):
    c = (q_last - N_META) // CHUNK
    return min(L, N_META + CHUNK * (c + 1))


def mla_attention(c_q, c_kv, k_rope, q_norm_g, w_uq, kv_norm_g, w_uk, w_uv, cos, sin):
    B, L, _ = c_q.shape
    q = jnp.einsum('blr,rhd->blhd', rms_norm(c_q, q_norm_g), w_uq)
    q_nope, q_rope = q[..., :QK_NOPE], q[..., QK_NOPE:]
    q_rope = apply_rope(q_rope, cos[None, :, None, :], sin[None, :, None, :])
    ckv = rms_norm(c_kv, kv_norm_g)
    k_nope = jnp.einsum('blr,rhd->blhd', ckv, w_uk)
    v = jnp.einsum('blr,rhd->blhd', ckv, w_uv)
    k_rope = apply_rope(k_rope, cos[None], sin[None])
    cid = (jnp.arange(L) - N_META) // CHUNK
    neg = jnp.finfo(jnp.float32).min
    outs = []
    for s in range(0, L, Q_BLOCK):
        e = min(s + Q_BLOCK, L)
        ke = key_extent(e - 1, L)
        sc = (jnp.einsum('bqhd,bkhd->bhqk', q_nope[:, s:e], k_nope[:, :ke])
              + jnp.einsum('bqhr,bkr->bhqk', q_rope[:, s:e], k_rope[:, :ke]))
        sc = sc.astype(jnp.float32) * ATTN_SCALE
        mask = cid[s:e, None] >= cid[None, :ke]
        sc = jnp.where(mask[None, None], sc, neg)
        p = jax.nn.softmax(sc, axis=-1).astype(v.dtype)
        outs.append(jnp.einsum('bhqk,bkhd->bqhd', p, v[:, :ke]))
    o = jnp.concatenate(outs, axis=1)
    return o.reshape(B, L, N_HEADS * V_DIM)


def token_mixer(u, w_in, pool_w, pool_scale, p_pool, q_norm_g, w_uq, kv_norm_g, w_uk,
                w_uv, p_mla, b_gate, w_out, cos, sin):
    B, L, _ = u.shape
    z = u @ w_in
    v_pool, c_q, c_kv, k_rope, g_logit = jnp.split(z, SPLIT_POINTS, axis=-1)
    y_pool = multiscale_pool(v_pool, pool_w, pool_scale) @ p_pool
    y_mla = mla_attention(c_q, c_kv, k_rope, q_norm_g, w_uq, kv_norm_g, w_uk, w_uv,
                          cos, sin) @ p_mla
    g = jax.nn.sigmoid(g_logit + b_gate).reshape(B, L, N_BRANCH, D_MODEL)
    merged = g[:, :, 0] * y_pool + g[:, :, 1] * y_mla
    return merged @ w_out


def conv_ffn(h, w_up, conv_w, conv_b, w_down):
    L = h.shape[1]
    a = h @ w_up
    ap = jnp.pad(a, ((0, 0), (CONV_W - 1, 0), (0, 0)))
    c = ap[:, 0:L] * conv_w[0]
    for k in range(1, CONV_W):
        c = c + ap[:, k:k + L] * conv_w[k]
    c = c + conv_b
    gate, up = jnp.split(c, 2, axis=-1)
    return (jax.nn.silu(gate) * up) @ w_down


def setup_inputs(seed: int = 0) -> dict:
    key = jax.random.key(seed)
    ks = jax.random.split(key, 32)
    f = jnp.float32
    n = lambda k, shape, s: jax.random.normal(k, shape, f) * s
    D = D_MODEL
    return {
        "x": n(ks[0], (BATCH, SEQ, D), 1.0),
        "meta": n(ks[1], (N_META, D), 1.0),
        "ln_in_g": 1.0 + n(ks[2], (D,), 0.02),
        "ln_in_b": n(ks[3], (D,), 0.02),
        "w_in": n(ks[4], (DEPTH, D, D_IN), D ** -0.5),
        "pool_w": n(ks[5], (DEPTH, POOL_GROUPS, POOL_GW, POOL_GW), POOL_GW ** -0.5),
        "pool_scale": 1.0 + n(ks[6], (DEPTH, D_POOL), 0.1),
        "p_pool": n(ks[7], (DEPTH, D_POOL, D), BETA * D_POOL ** -0.5),
        "q_norm_g": 1.0 + n(ks[8], (DEPTH, Q_LORA), 0.02),
        "w_uq": n(ks[9], (DEPTH, Q_LORA, N_HEADS, QK_NOPE + QK_ROPE), Q_LORA ** -0.5),
        "kv_norm_g": 1.0 + n(ks[10], (DEPTH, KV_LORA), 0.02),
        "w_uk": n(ks[11], (DEPTH, KV_LORA, N_HEADS, QK_NOPE), KV_LORA ** -0.5),
        "w_uv": n(ks[12], (DEPTH, KV_LORA, N_HEADS, V_DIM), KV_LORA ** -0.5),
        "p_mla": n(ks[13], (DEPTH, N_HEADS * V_DIM, D), BETA * (N_HEADS * V_DIM) ** -0.5),
        "b_gate": n(ks[14], (DEPTH, N_BRANCH * D), 0.01),
        "w_out": n(ks[15], (DEPTH, D, D), BETA * D ** -0.5),
        "ln1_g": 1.0 + n(ks[16], (DEPTH, D), 0.02),
        "ln1_b": n(ks[17], (DEPTH, D), 0.02),
        "w_ffn_up": n(ks[18], (DEPTH, D, 2 * D_FF), D ** -0.5),
        "ffn_conv_w": n(ks[19], (DEPTH, CONV_W, 2 * D_FF), CONV_W ** -0.5),
        "ffn_conv_b": n(ks[20], (DEPTH, 2 * D_FF), 0.02),
        "w_ffn_down": n(ks[21], (DEPTH, D_FF, D), BETA * D_FF ** -0.5),
        "ln2_g": 1.0 + n(ks[22], (DEPTH, D), 0.02),
        "ln2_b": n(ks[23], (DEPTH, D), 0.02),
    }


def reference(x, meta, ln_in_g, ln_in_b, w_in, pool_w, pool_scale, p_pool, q_norm_g,
              w_uq, kv_norm_g, w_uk, w_uv, p_mla, b_gate, w_out, ln1_g, ln1_b,
              w_ffn_up, ffn_conv_w, ffn_conv_b, w_ffn_down, ln2_g, ln2_b):
    B = x.shape[0]
    h = jnp.concatenate(
        [jnp.broadcast_to(meta[None].astype(x.dtype), (B, N_META, D_MODEL)), x], axis=1)
    L = h.shape[1]
    h = layer_norm(h, ln_in_g, ln_in_b)
    cos, sin = rope_tables(L, h.dtype)
    for i in range(DEPTH):
        t = token_mixer(h, w_in[i], pool_w[i], pool_scale[i], p_pool[i], q_norm_g[i],
                        w_uq[i], kv_norm_g[i], w_uk[i], w_uv[i], p_mla[i], b_gate[i],
                        w_out[i], cos, sin)
        h = layer_norm(ALPHA * h + t, ln1_g[i], ln1_b[i])
        f = conv_ffn(h, w_ffn_up[i], ffn_conv_w[i], ffn_conv_b[i], w_ffn_down[i])
        h = layer_norm(ALPHA * h + f, ln2_g[i], ln2_b[i])
    return h[:, N_META:]
```

```cpp
#include <hip/hip_runtime.h>
#include <hip/hip_cooperative_groups.h>
#include <hip/hip_bf16.h>
#include <cstdio>
#include <cstdint>
#include <cmath>
namespace cg = cooperative_groups;
namespace pg8 {
#define PG8_LAS __attribute__((address_space(3)))
typedef unsigned short bf16_t;
typedef short bf16x8 __attribute__((ext_vector_type(8)));
typedef float f32x4 __attribute__((ext_vector_type(4)));
typedef unsigned u32x4 __attribute__((ext_vector_type(4)));
constexpr int BM = 256, BK = 64, HALF = 128, HTB = HALF * BK * 2  , STAGE_BYTES = 8 * HTB, NXCD = 8, WGM = 8;

__host__ __device__ __forceinline__ int lds_byte(int r, int c) { const int st = (r >> 4) * 2 + (c >> 5), rr = r & 15, cc = c & 31, ob = rr * 64 + cc * 2; return st * 1024 + (ob ^ (((ob >> 9) & 1) << 5)); }
__host__ __device__ __forceinline__ void stage_rc(int b, int& R, int& C) { const int st = b / 1024, sb = b % 1024, swz = sb ^ (((sb >> 9) & 1) << 5); R = (st >> 1) * 16 + swz / 64; C = (st & 1) * 32 + (swz % 64) / 2; }
__host__ __device__ __forceinline__ int perm32(int rho) { const int n = rho >> 4, i = rho & 15; return 8 * (i >> 2) + 4 * n + (i & 3); }

struct Unit { int pm, pn; };
struct Gemm { const bf16_t* A; const bf16_t* Bt; int M, N, K; };

struct StaticOrder {
    int nM, nN, nwg, G, c;
    __host__ __device__ void init(int M, int N, int G_, int c_) { nM = M / BM; nN = N / BM; nwg = nM * nN; G = G_; c = c_; }
    __host__ __device__ bool next(int i, Unit& u) const {
        const long L = (long)i * G + c; if (L >= nwg) return false;
        int wgid = (int)L; { const int q = nwg / NXCD, r = nwg % NXCD, xcd = wgid % NXCD, off = wgid / NXCD; wgid = (xcd < r ? xcd * (q + 1) : r * (q + 1) + (xcd - r) * q) + off; }
        const int nig = WGM * nN, gid = wgid / nig, fm = gid * WGM, gsz = (nM - fm) < WGM ? (nM - fm) : WGM;
        u.pm = fm + ((wgid % nig) % gsz); u.pn = (wgid % nig) / gsz; return true;
    }
    __device__ __forceinline__ void a_ready(const Unit&) const {}
    __device__ __forceinline__ void done(const Unit&) const {}
};

__device__ __forceinline__ unsigned cvt_pk_bf16(float lo, float hi) { unsigned r; asm volatile("v_cvt_pk_bf16_f32 %0, %1, %2" : "=v"(r) : "v"(lo), "v"(hi)); return r; }
typedef float f32x2 __attribute__((ext_vector_type(2)));
__device__ __forceinline__ float bflo(unsigned w) { return __uint_as_float(w << 16); }
__device__ __forceinline__ float bfhi(unsigned w) { return __uint_as_float(w & 0xffff0000u); }
__device__ __forceinline__ float sigm(float x) { return __builtin_amdgcn_rcpf(1.0f + __builtin_amdgcn_exp2f(-1.4426950408889634f * x)); }
__device__ __forceinline__ u32x4 pack8(f32x4 a, f32x4 b) { u32x4 w; w.x = cvt_pk_bf16(a[0], a[1]); w.y = cvt_pk_bf16(a[2], a[3]); w.z = cvt_pk_bf16(b[0], b[1]); w.w = cvt_pk_bf16(b[2], b[3]); return w; }
typedef unsigned u32x2 __attribute__((ext_vector_type(2)));
__device__ __forceinline__ u32x2 pack4(f32x4 a) { u32x2 w; w.x = cvt_pk_bf16(a[0], a[1]); w.y = cvt_pk_bf16(a[2], a[3]); return w; }

struct EpiIn {
    static constexpr bool PERM = true, AFTER_DRAIN = false;
    bf16_t* VP; bf16_t* GATE; bf16_t* LAT; const float* bgate;
    __device__ __forceinline__ void operator()(const f32x4 (&acc)[2][2][4][2], const Unit& u, int wr, int wc, int fr, int fq) const {
        const int row0 = u.pm * BM + wr * 64 + fr;
        bf16_t* base; int ldc, colt; const float* bias = nullptr;
        if (u.pn < 2) { base = VP; ldc = 512; colt = u.pn * 256; }
        else if (u.pn < 10) { base = GATE; ldc = 2048; colt = (u.pn - 2) * 256; bias = bgate; }
        else { base = LAT; ldc = 768; colt = (u.pn - 10) * 256; }
        const int col0 = colt + wc * 32 + 8 * fq;
        f32x4 bv[2][2];
#pragma unroll
        for (int bj = 0; bj < 2; ++bj)
#pragma unroll
            for (int n = 0; n < 2; ++n) bv[bj][n] = bias ? *(const f32x4*)(bias + col0 + bj * HALF + 4 * n) : (f32x4){0.f, 0.f, 0.f, 0.f};
#pragma unroll
        for (int ai = 0; ai < 2; ++ai)
#pragma unroll
            for (int m = 0; m < 4; ++m) { bf16_t* rowp = base + (size_t)(row0 + ai * HALF + m * 16) * ldc + col0;
#pragma unroll
                for (int bj = 0; bj < 2; ++bj) { f32x4 v0 = acc[ai][bj][m][0] + bv[bj][0], v1 = acc[ai][bj][m][1] + bv[bj][1];
                    if (bias) {
#pragma unroll
                        for (int j = 0; j < 4; ++j) { v0[j] = sigm(v0[j]); v1[j] = sigm(v1[j]); } }
                    *(u32x4*)(rowp + bj * HALF) = pack8(v0, v1); } }
    }
};

struct EpiKV {
    static constexpr bool PERM = true, AFTER_DRAIN = false;
    bf16_t* KB; bf16_t* VB; int mode;
    __device__ __forceinline__ void operator()(const f32x4 (&acc)[2][2][4][2], const Unit& u, int wr, int wc, int fr, int fq) const {
        const int row0 = u.pm * BM + wr * 64 + fr;
#pragma unroll
        for (int ai = 0; ai < 2; ++ai)
#pragma unroll
            for (int m = 0; m < 4; ++m) { const size_t row = (size_t)(row0 + ai * HALF + m * 16);
#pragma unroll
                for (int bj = 0; bj < 2; ++bj) { const int c = u.pn * BM + bj * HALF + wc * 32 + 8 * fq;
                    bf16_t* p = mode ? KB + row * 768 + c : ((u.pn < 2) ? KB + row * 768 + (c >> 6) * 96 + (c & 63) : VB + row * 512 + (c - 512));
                    *(u32x4*)p = pack8(acc[ai][bj][m][0], acc[ai][bj][m][1]); } }
    }
};

struct EpiMerge {
    static constexpr bool PERM = true, AFTER_DRAIN = false;
    const bf16_t* GATE; bf16_t* T; int pass;
    __device__ __forceinline__ void operator()(const f32x4 (&acc)[2][2][4][2], const Unit& u, int wr, int wc, int fr, int fq) const {
        const int row0 = u.pm * BM + wr * 64 + fr;
#pragma unroll
        for (int ai = 0; ai < 2; ++ai)
#pragma unroll
            for (int m = 0; m < 4; ++m) { const size_t row = (size_t)(row0 + ai * HALF + m * 16);
#pragma unroll
                for (int bj = 0; bj < 2; ++bj) { const int c = u.pn * BM + bj * HALF + wc * 32 + 8 * fq;
                    const u32x4 g = *(const u32x4*)(GATE + row * 2048 + pass * 1024 + c);
                    f32x4 v0 = acc[ai][bj][m][0], v1 = acc[ai][bj][m][1];
                    v0 = v0 * (f32x4){bflo(g.x), bfhi(g.x), bflo(g.y), bfhi(g.y)}; v1 = v1 * (f32x4){bflo(g.z), bfhi(g.z), bflo(g.w), bfhi(g.w)};
                    bf16_t* p = T + row * 1024 + c;
                    if (pass) { const u32x4 t = *(const u32x4*)p; v0 = v0 + (f32x4){bflo(t.x), bfhi(t.x), bflo(t.y), bfhi(t.y)}; v1 = v1 + (f32x4){bflo(t.z), bfhi(t.z), bflo(t.w), bfhi(t.w)}; }
                    *(u32x4*)p = pack8(v0, v1); } }
    }
};

struct EpiOut {
    static constexpr bool PERM = true, AFTER_DRAIN = false;
    const float* x; const float* meta; const float* stats; const float* g; const float* b; float* out; float* xmeta; float alpha;
    __device__ __forceinline__ void operator()(const f32x4 (&acc)[2][2][4][2], const Unit& u, int wr, int wc, int fr, int fq) const {
        const int row0 = u.pm * BM + wr * 64 + fr;
#pragma unroll
        for (int bj = 0; bj < 2; ++bj) { const int c = u.pn * BM + bj * HALF + wc * 32 + 8 * fq;
            const f32x4 g0 = *(const f32x4*)(g + c), g1 = *(const f32x4*)(g + c + 4), b0 = *(const f32x4*)(b + c), b1 = *(const f32x4*)(b + c + 4);
#pragma unroll
            for (int ai = 0; ai < 2; ++ai)
#pragma unroll
                for (int m = 0; m < 4; ++m) { const int row = row0 + ai * HALF + m * 16;
                    const float* src; float* dst;
                    if (row < 32768) { src = x + (size_t)row * 1024 + c; dst = out + (size_t)row * 1024 + c; }
                    else { const int rr = row - 32768; src = rr < 16 ? meta + (size_t)rr * 1024 + c : nullptr; dst = xmeta + (size_t)rr * 1024 + c; }
                    f32x4 h0 = (f32x4){0.f, 0.f, 0.f, 0.f}, h1 = h0;
                    if (src) { const float mean = stats[2 * row], rstd = stats[2 * row + 1];
                        h0 = (*(const f32x4*)src - mean) * rstd * g0 + b0; h1 = (*(const f32x4*)(src + 4) - mean) * rstd * g1 + b1; }
                    *(f32x4*)dst = h0 * alpha + acc[ai][bj][m][0]; *(f32x4*)(dst + 4) = h1 * alpha + acc[ai][bj][m][1]; }
        }
    }
};

__device__ __forceinline__ float dpp_shr1(float cur, float prev) {
    const int t = __builtin_amdgcn_update_dpp(0, __float_as_int(prev), 0x121, 0xf, 0xf, false);
    return __int_as_float(__builtin_amdgcn_update_dpp(t, __float_as_int(cur), 0x111, 0xf, 0xf, false));
}
__device__ __forceinline__ float dpp_shr2(float cur, float prev) {
    const int t = __builtin_amdgcn_update_dpp(0, __float_as_int(prev), 0x122, 0xf, 0xf, false);
    return __int_as_float(__builtin_amdgcn_update_dpp(t, __float_as_int(cur), 0x112, 0xf, 0xf, false));
}
struct EpiUp {
    static constexpr bool PERM = false, AFTER_DRAIN = false;
    const float* cw; const float* cb; bf16_t* ACT; bf16_t* HALO;
    __device__ __forceinline__ void operator()(const f32x4 (&acc)[2][2][4][2], const Unit& u, int wr, int wc, int fr, int fq) const {
#pragma unroll
        for (int n = 0; n < 2; ++n) {
            const int jcol = u.pn * 128 + wc * 32 + 16 * n + 4 * fq;
            const int dcol = u.pn * 256 + wc * 32 + 16 * n + 4 * fq;
            const f32x4 wg0 = *(const f32x4*)(cw + jcol), wg1 = *(const f32x4*)(cw + 5632 + jcol), wg2 = *(const f32x4*)(cw + 2 * 5632 + jcol), bg = *(const f32x4*)(cb + jcol);
            const f32x4 wu0 = *(const f32x4*)(cw + 2816 + jcol), wu1 = *(const f32x4*)(cw + 5632 + 2816 + jcol), wu2 = *(const f32x4*)(cw + 2 * 5632 + 2816 + jcol), bu = *(const f32x4*)(cb + 2816 + jcol);
#pragma unroll
            for (int ai = 0; ai < 2; ++ai) {
                f32x4 pg = (f32x4){0.f, 0.f, 0.f, 0.f}, pu = pg;
#pragma unroll
                for (int m = 0; m < 4; ++m) {
                    const f32x4 ag = acc[ai][0][m][n], au = acc[ai][1][m][n];
                    f32x4 g1, g2, u1, u2;
#pragma unroll
                    for (int j = 0; j < 4; ++j) { g1[j] = dpp_shr1(ag[j], pg[j]); g2[j] = dpp_shr2(ag[j], pg[j]); u1[j] = dpp_shr1(au[j], pu[j]); u2[j] = dpp_shr2(au[j], pu[j]); }
                    const f32x4 cgv = wg2 * ag + wg1 * g1 + wg0 * g2 + bg, cuv = wu2 * au + wu1 * u1 + wu0 * u2 + bu;
                    f32x4 a;
#pragma unroll
                    for (int j = 0; j < 4; ++j) a[j] = cgv[j] * sigm(cgv[j]) * cuv[j];
                    const int row = u.pm * BM + ai * HALF + wr * 64 + m * 16 + fr;
                    if (!(m == 0 && fr < 2)) *(u32x2*)(ACT + (size_t)row * 2816 + jcol) = pack4(a);
                    if ((m == 0 && fr < 2) || (m == 3 && fr >= 14)) {
                        const int slot = (m == 0) ? fr : fr - 12, g64 = u.pm * 4 + ai * 2 + wr;
                        bf16_t* hp = HALO + ((size_t)g64 * 4 + slot) * 5632 + dcol;
                        *(u32x2*)hp = pack4(ag); *(u32x2*)(hp + 128) = pack4(au);
                    }
                    pg = ag; pu = au;
                }
            }
        }
    }
};

struct EpiDown {
    static constexpr bool PERM = true, AFTER_DRAIN = false;
    float* out; const float* stats; const float* g; const float* b; float alpha;
    __device__ __forceinline__ void operator()(const f32x4 (&acc)[2][2][4][2], const Unit& u, int wr, int wc, int fr, int fq) const {
        const int row0 = u.pm * BM + wr * 64 + fr;
#pragma unroll
        for (int bj = 0; bj < 2; ++bj) { const int c = u.pn * BM + bj * HALF + wc * 32 + 8 * fq;
            const f32x4 g0 = *(const f32x4*)(g + c), g1 = *(const f32x4*)(g + c + 4), b0 = *(const f32x4*)(b + c), b1 = *(const f32x4*)(b + c + 4);
#pragma unroll
            for (int ai = 0; ai < 2; ++ai)
#pragma unroll
                for (int m = 0; m < 4; ++m) { const int row = row0 + ai * HALF + m * 16;
                    float* p = out + (size_t)row * 1024 + c; const float mean = stats[2 * row], rstd = stats[2 * row + 1];
                    const f32x4 h0 = (*(const f32x4*)p - mean) * rstd * g0 + b0, h1 = (*(const f32x4*)(p + 4) - mean) * rstd * g1 + b1;
                    *(f32x4*)p = h0 * alpha + acc[ai][bj][m][0]; *(f32x4*)(p + 4) = h1 * alpha + acc[ai][bj][m][1]; }
        }
    }
};
template <class Epi, class Sched, bool ALIGN_EPI = false, bool SP2 = false>
__device__ __forceinline__ void gemm_phase(PG8_LAS unsigned char* lds, const Gemm g, const Sched& S, const Epi& E) {
    const int tid = threadIdx.x, wid = __builtin_amdgcn_readfirstlane(tid >> 6), lane = tid & 63, wr = wid >> 2, wc = wid & 3, fr = lane & 15, fq = lane >> 4;
    const int K = g.K, nt = K / BK;
    unsigned voffA[2], voffB[2];
#pragma unroll
    for (int i = 0; i < 2; ++i) { int R, C; stage_rc(tid * 16 + i * 8192, R, C); const int Rb = Epi::PERM ? ((R & ~31) + perm32(R & 31)) : R;
        voffA[i] = (unsigned)(R * K + C) * 2u; voffB[i] = (unsigned)(Rb * K + C) * 2u; }
    const size_t kstep = (size_t)(BK * 2);
    const size_t hstep = (size_t)HALF * K * 2;
    const size_t tstep = 2 * hstep;
    const unsigned ldsw = (unsigned)wid * 1024u;
    const int aoff = lds_byte(wr * 64 + fr, fq * 8), boff = lds_byte(wc * 32 + fr, fq * 8);
#define PG8_SA(b, h) (((b) * 2 + (h)) * HTB)
#define PG8_SB(b, h) ((4 + (b) * 2 + (h)) * HTB)
#define PG8_STAGE(bufoff, gbase, voff) do { _Pragma("unroll") for (int _i = 0; _i < 2; ++_i) \
        __builtin_amdgcn_global_load_lds((const unsigned*)((const char*)(gbase) + (voff)[_i]), (PG8_LAS unsigned*)(lds + (bufoff) + ldsw + _i * 8192), 16, 0, 0); } while (0)
#define PG8_LDA(dst, b, h) do { _Pragma("unroll") for (int m = 0; m < 4; ++m) _Pragma("unroll") for (int k = 0; k < 2; ++k) dst[m][k] = *(const PG8_LAS bf16x8*)(lds + PG8_SA(b, h) + aoff + m * 2048 + k * 1024); } while (0)
#define PG8_LDB(dst, b, h) do { _Pragma("unroll") for (int n = 0; n < 2; ++n) _Pragma("unroll") for (int k = 0; k < 2; ++k) dst[n][k] = *(const PG8_LAS bf16x8*)(lds + PG8_SB(b, h) + boff + n * 2048 + k * 1024); } while (0)
#define PG8_MMA(ai, bj, At, Bt) do { __builtin_amdgcn_s_setprio(1); _Pragma("unroll") for (int m = 0; m < 4; ++m) _Pragma("unroll") for (int n = 0; n < 2; ++n) _Pragma("unroll") for (int k = 0; k < 2; ++k) \
        acc[ai][bj][m][n] = __builtin_amdgcn_mfma_f32_16x16x32_bf16(Bt[n][k], At[m][k], acc[ai][bj][m][n], 0, 0, 0); __builtin_amdgcn_s_setprio(0); } while (0)
#define PG8_WAIT_V(n) asm volatile("s_waitcnt vmcnt(" #n ")" ::: "memory")
#define PG8_WAIT_L(n) asm volatile("s_waitcnt lgkmcnt(" #n ")" ::: "memory")
#define PG8_BAR __builtin_amdgcn_s_barrier()
#define PG8_SCHED __builtin_amdgcn_sched_barrier(0)
    Unit cur, nxt; int ui = 0;
    if (!S.next(0, cur)) return;
    f32x4 acc[2][2][4][2];
#pragma unroll
    for (int a = 0; a < 2; ++a)
#pragma unroll
        for (int b = 0; b < 2; ++b)
#pragma unroll
            for (int m = 0; m < 4; ++m)
#pragma unroll
                for (int n = 0; n < 2; ++n) acc[a][b][m][n] = (f32x4){0.f, 0.f, 0.f, 0.f};
    bf16x8 At[4][2], B0[2][2], B1[2][2];
    const char* cA = (const char*)g.A + (size_t)cur.pm * tstep; const char* cB = (const char*)g.Bt + (size_t)cur.pn * tstep;
    S.a_ready(cur);
    if constexpr (SP2) {
        PG8_STAGE(PG8_SB(0, 0), cB, voffB); PG8_STAGE(PG8_SB(0, 1), cB + hstep, voffB); PG8_STAGE(PG8_SA(0, 0), cA, voffA); PG8_STAGE(PG8_SA(0, 1), cA + hstep, voffA);
        if (wr == 1) PG8_BAR;
        PG8_WAIT_V(2); PG8_BAR;
        PG8_STAGE(PG8_SB(1, 0), cB + kstep, voffB); PG8_STAGE(PG8_SA(1, 0), cA + kstep, voffA); PG8_STAGE(PG8_SB(1, 1), cB + hstep + kstep, voffB);
        PG8_WAIT_V(6); PG8_BAR;
    } else {
        PG8_STAGE(PG8_SB(0, 0), cB, voffB); PG8_STAGE(PG8_SA(0, 0), cA, voffA); PG8_STAGE(PG8_SB(0, 1), cB + hstep, voffB); PG8_STAGE(PG8_SA(0, 1), cA + hstep, voffA);
        if (wr == 1) PG8_BAR;
        PG8_WAIT_V(4); PG8_BAR;
        PG8_STAGE(PG8_SB(1, 0), cB + kstep, voffB); PG8_STAGE(PG8_SA(1, 0), cA + kstep, voffA); PG8_STAGE(PG8_SB(1, 1), cB + hstep + kstep, voffB);
        PG8_WAIT_V(6); PG8_BAR;
    }
    for (;;) {
        const bool has_next = S.next(ui + 1, nxt);
        const char* nA = has_next ? (const char*)g.A + (size_t)nxt.pm * tstep : cA; const char* nB = has_next ? (const char*)g.Bt + (size_t)nxt.pn * tstep : cB;
        for (int t = 0; t < nt; t += 2) {
            const bool last = (t == nt - 2);
            const char* a1 = cA + (size_t)(t + 1) * kstep;
            const char* a2 = last ? nA : cA + (size_t)(t + 2) * kstep; const char* b2 = last ? nB : cB + (size_t)(t + 2) * kstep;
            const char* a3 = a2 + kstep; const char* b3 = b2 + kstep;
            if (last && has_next) S.a_ready(nxt);
            if constexpr (SP2) {
            PG8_LDB(B0, 0, 0); PG8_LDB(B1, 0, 1); PG8_SCHED; PG8_LDA(At, 0, 0); PG8_STAGE(PG8_SA(1, 1), a1 + hstep, voffA);
            PG8_WAIT_V(8); PG8_WAIT_L(0); PG8_BAR; PG8_MMA(0, 0, At, B0); PG8_MMA(0, 1, At, B1); PG8_BAR; PG8_SCHED;
            PG8_LDA(At, 0, 1); PG8_STAGE(PG8_SB(0, 0), b2, voffB); PG8_STAGE(PG8_SB(0, 1), b2 + hstep, voffB); PG8_STAGE(PG8_SA(0, 0), a2, voffA);
            PG8_WAIT_V(8); PG8_WAIT_L(0); PG8_BAR; PG8_MMA(1, 0, At, B0); PG8_MMA(1, 1, At, B1); PG8_BAR; PG8_SCHED;
            PG8_LDB(B0, 1, 0); PG8_LDB(B1, 1, 1); PG8_SCHED; PG8_LDA(At, 1, 0); PG8_STAGE(PG8_SA(0, 1), a2 + hstep, voffA);
            PG8_WAIT_V(8); PG8_WAIT_L(0); PG8_BAR; PG8_MMA(0, 0, At, B0); PG8_MMA(0, 1, At, B1); PG8_BAR; PG8_SCHED;
            PG8_LDA(At, 1, 1); PG8_STAGE(PG8_SB(1, 0), b3, voffB); PG8_STAGE(PG8_SB(1, 1), b3 + hstep, voffB); PG8_STAGE(PG8_SA(1, 0), a3, voffA);
            PG8_WAIT_V(8); PG8_WAIT_L(0); PG8_BAR; PG8_MMA(1, 0, At, B0); PG8_MMA(1, 1, At, B1); PG8_BAR; PG8_SCHED;
            } else {
            PG8_LDB(B0, 0, 0); PG8_SCHED; PG8_LDA(At, 0, 0); PG8_STAGE(PG8_SA(1, 1), a1 + hstep, voffA);
            PG8_WAIT_L(8); PG8_BAR; PG8_WAIT_L(0); PG8_MMA(0, 0, At, B0); PG8_BAR; PG8_SCHED;
            PG8_LDB(B1, 0, 1); PG8_STAGE(PG8_SB(0, 0), b2, voffB);
            PG8_BAR; PG8_WAIT_L(0); PG8_MMA(0, 1, At, B1); PG8_BAR;
            PG8_LDA(At, 0, 1); PG8_STAGE(PG8_SA(0, 0), a2, voffA);
            PG8_BAR; PG8_WAIT_L(0); PG8_MMA(1, 0, At, B0); PG8_BAR; PG8_SCHED;
            PG8_STAGE(PG8_SB(0, 1), b2 + hstep, voffB);
            PG8_WAIT_V(6); PG8_BAR; PG8_MMA(1, 1, At, B1); PG8_BAR;
            PG8_LDB(B0, 1, 0); PG8_SCHED; PG8_LDA(At, 1, 0); PG8_STAGE(PG8_SA(0, 1), a2 + hstep, voffA);
            PG8_WAIT_L(8); PG8_BAR; PG8_WAIT_L(0); PG8_MMA(0, 0, At, B0); PG8_BAR; PG8_SCHED;
            PG8_LDB(B1, 1, 1); PG8_STAGE(PG8_SB(1, 0), b3, voffB);
            PG8_BAR; PG8_WAIT_L(0); PG8_MMA(0, 1, At, B1); PG8_BAR;
            PG8_LDA(At, 1, 1); PG8_STAGE(PG8_SA(1, 0), a3, voffA);
            PG8_BAR; PG8_WAIT_L(0); PG8_MMA(1, 0, At, B0); PG8_BAR; PG8_SCHED;
            PG8_STAGE(PG8_SB(1, 1), b3 + hstep, voffB);
            PG8_WAIT_V(6); PG8_BAR; PG8_MMA(1, 1, At, B1); PG8_BAR;
            }
        }
        if constexpr (ALIGN_EPI) { if (wr == 0) PG8_BAR; }
        if constexpr (!Epi::AFTER_DRAIN) { E(acc, cur, wr, wc, fr, fq); S.done(cur); }
        if (!has_next) break;
#pragma unroll
        for (int a = 0; a < 2; ++a)
#pragma unroll
            for (int b = 0; b < 2; ++b)
#pragma unroll
                for (int m = 0; m < 4; ++m)
#pragma unroll
                    for (int n = 0; n < 2; ++n) acc[a][b][m][n] = (f32x4){0.f, 0.f, 0.f, 0.f};
        cur = nxt; cA = nA; cB = nB; ++ui;
        if constexpr (ALIGN_EPI) { if (wr == 1) PG8_BAR; }
    }
    PG8_WAIT_V(0);
    if constexpr (!ALIGN_EPI) { if (wr == 0) PG8_BAR; }
    PG8_BAR;
    if constexpr (Epi::AFTER_DRAIN) { E.fused(acc, cur, wr, wc, fr, fq, lds, wid, lane); S.done(cur); }
#undef PG8_SA
#undef PG8_SB
#undef PG8_STAGE
#undef PG8_LDA
#undef PG8_LDB
#undef PG8_MMA
#undef PG8_WAIT_V
#undef PG8_WAIT_L
#undef PG8_BAR
#undef PG8_SCHED
}
}
namespace att {
using bf16=__hip_bfloat16;
using bf16x8=__attribute__((ext_vector_type(8)))short;
using s16x4=__attribute__((ext_vector_type(4)))short;
using f32x16=__attribute__((ext_vector_type(16)))float;
using u32x4=__attribute__((ext_vector_type(4)))unsigned;
__device__ __forceinline__ int crow(int r,int hi){return (r&3)+8*(r>>2)+4*hi;}
#define SBAR() __builtin_amdgcn_sched_barrier(0)
__device__ __forceinline__ void glds16(const void*gsrc,unsigned lds_dst){unsigned keep;
  asm volatile("s_mov_b32 %0, m0\n\ts_mov_b32 m0, %2\n\ts_nop 0\n\tglobal_load_lds_dwordx4 %1, off\n\ts_mov_b32 m0, %0":"=&s"(keep):"v"(gsrc),"s"(lds_dst):"memory");}
__device__ __forceinline__ float max3f(float a,float b,float c){float r;asm("v_max3_f32 %0, %1, %2, %3":"=v"(r):"v"(a),"v"(b),"v"(c));return r;}
__device__ __forceinline__ float max2f(float a,float b){float r;asm("v_max_f32_e32 %0, %1, %2":"=v"(r):"v"(a),"v"(b));return r;}
__device__ __forceinline__ float fadd_s(float a,float b){float r;asm("v_add_f32_e32 %0, %1, %2":"=v"(r):"v"(a),"v"(b));return r;}
__device__ __forceinline__ float fsub_s(float a,float b){float r;asm("v_sub_f32_e32 %0, %1, %2":"=v"(r):"v"(a),"v"(b));return r;}
typedef float f32x2_t __attribute__((ext_vector_type(2))); typedef __bf16 bf16x2_t __attribute__((ext_vector_type(2)));
__device__ __forceinline__ unsigned cvtpk_s(float lo,float hi){f32x2_t v={lo,hi};bf16x2_t b=__builtin_convertvector(v,bf16x2_t);return __builtin_bit_cast(unsigned,b);}
typedef __attribute__((address_space(3))) const char* lds_cptr;
typedef short v4i16_t __attribute__((ext_vector_type(4)));
__device__ __forceinline__ float rowmax(const f32x16&p0,const f32x16&p1){
  float a=max3f(p0[0],p0[1],p1[0]),b=max3f(p0[2],p0[3],p1[1]);a=max3f(a,p1[2],p1[3]);
  #pragma unroll
  for(int r=4;r<16;r+=4){a=max3f(a,p0[r],p0[r+1]);b=max3f(b,p0[r+2],p0[r+3]);a=max3f(a,p1[r],p1[r+1]);b=max3f(b,p1[r+2],p1[r+3]);}
  const float m=max2f(a,b);
  auto rr=__builtin_amdgcn_permlane32_swap(__float_as_uint(m),__float_as_uint(m),false,false);
  return max2f(__uint_as_float(rr[0]),__uint_as_float(rr[1]));
}
__device__ __forceinline__ void pv(f32x16*o,int vb,bf16x8 pa0,bf16x8 pa1,bf16x8 pa2,bf16x8 pa3){
  #pragma unroll
  for(int d0=0;d0<2;++d0){s16x4 lo[4],hi[4];
    #pragma unroll
    for(int ks=0;ks<4;++ks){
      asm volatile("ds_read_b64_tr_b16 %0,%1 offset:%c2":"=&v"(lo[ks]):"v"(vb),"i"(d0*4096+ks*1024):"memory");
      asm volatile("ds_read_b64_tr_b16 %0,%1 offset:%c2":"=&v"(hi[ks]):"v"(vb),"i"(d0*4096+ks*1024+512):"memory");}
    asm volatile("s_waitcnt lgkmcnt(0)":::"memory");SBAR();
    #define PK(k) (bf16x8){lo[k][0],lo[k][1],lo[k][2],lo[k][3],hi[k][0],hi[k][1],hi[k][2],hi[k][3]}
    o[d0]=__builtin_amdgcn_mfma_f32_32x32x16_bf16(pa0,PK(0),o[d0],0,0,0);
    o[d0]=__builtin_amdgcn_mfma_f32_32x32x16_bf16(pa1,PK(1),o[d0],0,0,0);
    o[d0]=__builtin_amdgcn_mfma_f32_32x32x16_bf16(pa2,PK(2),o[d0],0,0,0);
    o[d0]=__builtin_amdgcn_mfma_f32_32x32x16_bf16(pa3,PK(3),o[d0],0,0,0);
    #undef PK
  }
}
constexpr int KSLOT = 12288, VSLOT = 8192;
constexpr int L_K = 0, L_V = 2 * KSLOT, L_WS = L_V + 2 * VSLOT, L_OST = L_WS + 8 * 64 * 4, L_BYTES = L_OST + 8 * 4096;
typedef __attribute__((address_space(3))) float* lds_fptr;
__device__ __forceinline__ void attn_unit(long qrow0, long kvrow0, int h, int NT, int qb4, const bf16* Q, const bf16* __restrict__ K, const bf16* __restrict__ V, bf16* O, const float* rope, char* shm) {
  const int tid = threadIdx.x, lane = tid & 63, r32 = lane & 31, hi = lane >> 5; const int wid = __builtin_amdgcn_readfirstlane(tid >> 6);
  const bf16* Qw = Q + (qrow0 + wid * 32) * 768 + h * 96;
  const unsigned lds0 = (unsigned)(uintptr_t)shm;
  const lds_cptr shm3 = (lds_cptr)shm;
  const lds_fptr wsf = (lds_fptr)(shm3 + L_WS) + wid * 64;
  const bf16* Kh = K + h * 96; const bf16* Vh = V + h * 64;
  const long koff = (long)lane * 768 + wid * 8;
  const long voff = (long)(16 * (wid & 3) + (lane >> 2)) * 512 + (wid >> 2) * 32 + (lane & 3) * 8;
#define ATT_DMA(t, slot) do { const long trow_ = ((t) == 0) ? 32768l : kvrow0 + (long)((t) - 1) * 64; \
    const bf16* kt_ = Kh + trow_ * 768 + koff; \
    glds16(kt_, (unsigned)__builtin_amdgcn_readfirstlane(lds0 + L_K + (slot) * KSLOT + wid * 1024)); \
    if (wid < 4) glds16(kt_ + 64, (unsigned)__builtin_amdgcn_readfirstlane(lds0 + L_K + (slot) * KSLOT + (8 + wid) * 1024)); \
    glds16(Vh + trow_ * 512 + voff, (unsigned)__builtin_amdgcn_readfirstlane(lds0 + L_V + (slot) * VSLOT + wid * 1024)); } while (0)
  ATT_DMA(0, 0);
  bf16x8 qr[6];
#pragma unroll
  for (int d0 = 0; d0 < 6; ++d0) qr[d0] = *reinterpret_cast<const bf16x8*>(&Qw[(long)r32 * 768 + d0 * 16 + hi * 8]);
  {
    const long qrow = qrow0 + wid * 32 + r32; const int pos = (qb4 < 0) ? (int)(qrow - 32768) : (int)(qrow & 4095) + 16;
    const float* rp = rope + ((size_t)pos * 16 + 8 * hi) * 2;
    bf16x8 a = qr[4], b = qr[5];
#pragma unroll
    for (int jj = 0; jj < 4; ++jj) { const __attribute__((ext_vector_type(4))) float cs = *(const __attribute__((ext_vector_type(4))) float*)(rp + 4 * jj);
#pragma unroll
      for (int e = 0; e < 2; ++e) { const int j = 2 * jj + e; const float c = cs[2 * e], sn = cs[2 * e + 1];
        const float x1 = __uint_as_float((unsigned)(unsigned short)a[j] << 16), x2 = __uint_as_float((unsigned)(unsigned short)b[j] << 16);
        const unsigned w = cvtpk_s(x1 * c - x2 * sn, x2 * c + x1 * sn);
        a[j] = (short)(w & 0xffffu); b[j] = (short)(w >> 16); } }
    qr[4] = a; qr[5] = b; }
  const int nvis = (qb4 < 0) ? 1 : 2 + qb4 + (wid >> 1);
  const int vb0 = (int)(lds0 + L_V) + ((lane >> 4) & 1) * 32 + (lane & 3) * 8 + (4 * hi + ((lane & 15) >> 2)) * 64;
  float m_run = -1e30f, l_run = 0.f; f32x16 o[2]; o[0] = f32x16{}; o[1] = f32x16{};
  for (int t = 0; t < NT; ++t) {
    asm volatile("s_waitcnt vmcnt(0) lgkmcnt(0)\n\ts_barrier" ::: "memory");
    if (t + 1 < NT) ATT_DMA(t + 1, (t + 1) & 1);
    if (t < nvis) {
      const int slot = t & 1;
      const lds_cptr kp = shm3 + L_K + slot * KSLOT + hi * 1024 + r32 * 16;
      f32x16 p0 = f32x16{}, p1 = f32x16{};
#pragma unroll
      for (int d0 = 0; d0 < 6; ++d0) {
        const bf16x8 b0 = *(const __attribute__((address_space(3))) bf16x8*)(kp + d0 * 2048);
        const bf16x8 b1 = *(const __attribute__((address_space(3))) bf16x8*)(kp + d0 * 2048 + 512);
        p0 = __builtin_amdgcn_mfma_f32_32x32x16_bf16(b0, qr[d0], p0, 0, 0, 0);
        p1 = __builtin_amdgcn_mfma_f32_32x32x16_bf16(b1, qr[d0], p1, 0, 0, 0);
      }
      if (t == 0) {
#pragma unroll
        for (int r = 0; r < 16; ++r) { if (r >= 8) p0[r] = -1e30f; p1[r] = -1e30f; }
      }
      const float rm = rowmax(p0, p1);
      const float m_new = fmaxf(m_run, rm);
      const float f = __builtin_amdgcn_exp2f(m_run - m_new);
      m_run = m_new;
      float sacc = 0.f;
#pragma unroll
      for (int r = 0; r < 16; ++r) { p0[r] = __builtin_amdgcn_exp2f(p0[r] - m_new); p1[r] = __builtin_amdgcn_exp2f(p1[r] - m_new); sacc += p0[r] + p1[r]; }
      l_run = l_run * f + sacc;
      if (hi == 0) wsf[r32] = f;
      asm volatile("s_waitcnt lgkmcnt(0)" ::: "memory");
#pragma unroll
      for (int r = 0; r < 16; ++r) { const float fr_ = wsf[crow(r, hi)]; o[0][r] *= fr_; o[1][r] *= fr_; }
      u32x4 pw0, pw1, pw2, pw3;
#define PKW(P, B) cvtpk_s(P[B], P[(B) + 1])
      pw0 = (u32x4){PKW(p0, 0), PKW(p0, 2), PKW(p0, 4), PKW(p0, 6)}; pw1 = (u32x4){PKW(p0, 8), PKW(p0, 10), PKW(p0, 12), PKW(p0, 14)};
      pw2 = (u32x4){PKW(p1, 0), PKW(p1, 2), PKW(p1, 4), PKW(p1, 6)}; pw3 = (u32x4){PKW(p1, 8), PKW(p1, 10), PKW(p1, 12), PKW(p1, 14)};
#undef PKW
      SBAR();
      pv(o, vb0 + slot * VSLOT, __builtin_bit_cast(bf16x8, pw0), __builtin_bit_cast(bf16x8, pw1), __builtin_bit_cast(bf16x8, pw2), __builtin_bit_cast(bf16x8, pw3));
    }
  }
#undef ATT_DMA
  { auto rr = __builtin_amdgcn_permlane32_swap(__float_as_uint(l_run), __float_as_uint(l_run), false, false); l_run = __uint_as_float(rr[0]) + __uint_as_float(rr[1]); }
  if (hi == 0) wsf[32 + r32] = l_run;
  asm volatile("s_waitcnt lgkmcnt(0)" ::: "memory");
  float rli[16];
#pragma unroll
  for (int r = 0; r < 16; ++r) rli[r] = __builtin_amdgcn_rcpf(wsf[32 + crow(r, hi)]);
  bf16* Ow = O + (qrow0 + wid * 32) * 512 + h * 64;
  { bf16* stg = (bf16*)(shm + L_OST) + wid * 2048;
#pragma unroll
    for (int r = 0; r < 16; ++r) { const int orow = crow(r, hi);
#pragma unroll
      for (int d0 = 0; d0 < 2; ++d0) stg[orow * 64 + d0 * 32 + r32] = __float2bfloat16(o[d0][r] * rli[r]); }
    asm volatile("s_waitcnt lgkmcnt(0)" ::: "memory");
#pragma unroll
    for (int i = 0; i < 4; ++i) { const int row = i * 8 + (lane >> 3), ch = lane & 7; const u32x4 v = *(const u32x4*)(stg + row * 64 + ch * 8); *(u32x4*)(Ow + (long)row * 512 + ch * 8) = v; } }
  asm volatile("s_waitcnt lgkmcnt(0)\n\ts_barrier" ::: "memory");
}
#undef SBAR
}
constexpr int NWAVES = 8;
constexpr int MR = 32768;
constexpr int MP = 33024;
constexpr int DMODEL = 1024, DPOOL = 512, QLORA = 384, KVLORA = 256, DFF = 2816;
constexpr float LN_EPS = 1e-6f;
constexpr float ALPHA = 1.189207115002721f;
constexpr float QSCALE = 0.10206207261596575f * 1.4426950408889634f;
constexpr size_t MiB = 1u << 20;
constexpr size_t WS_STATS0 = 0, WS_STATS1 = 512 * 1024, WS_ROPE = 1 * MiB, WS_XMETA = 2 * MiB, WS_AMETA = 3 * MiB;
constexpr size_t WS_WIN = 4 * MiB, WS_WPP = WS_WIN + 13 * MiB / 2, WS_WUQ = WS_WPP + MiB, WS_WUKV = WS_WUQ + MiB, WS_PMLA = WS_WUKV + MiB / 2, WS_WOUT = WS_PMLA + MiB, WS_WUP = WS_WOUT + 2 * MiB, WS_WDOWN = WS_WUP + 11 * MiB;
static_assert(WS_WDOWN + 6 * MiB <= 36 * MiB, "weights");
constexpr size_t WS_A = 36 * MiB, WS_G = 101 * MiB, WS_VP = 231 * MiB, WS_LAT = 264 * MiB, WS_DP = 313 * MiB, WS_CQN = 346 * MiB, WS_CKVN = 371 * MiB, WS_KB = 388 * MiB, WS_VB = 437 * MiB, WS_HALO = 470 * MiB, WS_END = 493 * MiB;
constexpr size_t WS_ACT = WS_G;

#define GAS __attribute__((address_space(1)))
#define LAS __attribute__((address_space(3)))
typedef unsigned short bf16;
typedef unsigned v4u __attribute__((ext_vector_type(4)));
typedef unsigned v2u __attribute__((ext_vector_type(2)));
typedef float f32x4 __attribute__((ext_vector_type(4)));
typedef float f32x2 __attribute__((ext_vector_type(2)));
#define LDS_WAIT() asm volatile("s_waitcnt lgkmcnt(0)" ::: "memory")
__device__ __forceinline__ unsigned f2bf(float f) { unsigned u = __builtin_bit_cast(unsigned, f); return (u + 0x7fffu + ((u >> 16) & 1u)) >> 16; }
__device__ __forceinline__ unsigned pk2(float lo, float hi) { return f2bf(lo) | (f2bf(hi) << 16); }
__device__ __forceinline__ float blo(unsigned w) { return __uint_as_float(w << 16); }
__device__ __forceinline__ float bhi(unsigned w) { return __uint_as_float(w & 0xffff0000u); }
__device__ __forceinline__ float wave_sum(float v) {
#pragma unroll
    for (int o = 1; o < 64; o <<= 1) v += __shfl_xor(v, o);
    return v;
}

struct Args { const float* in[24]; float* out; unsigned char* ws; int ph_lo, ph_hi; };

__device__ __forceinline__ int remap_col(int mode, int n0) {
    if (mode == 1) return n0 < 512 ? n0 : (n0 < 1184 ? n0 + 2048 : n0 - 672);
    if (mode == 2) { const int j = n0 < 2816 ? n0 : n0 - 2816; return (j >> 7) * 256 + (j & 127) + (n0 < 2816 ? 0 : 128); }
    return n0;
}
__device__ __forceinline__ void p0_transpose_item(const float* W, int K, int N, bf16* WT, int row_off, int mode, LAS float* scr, int item, int lane) {
    const int nblk = N / 32, kb = item / nblk, nb = item % nblk, k0 = 64 * kb, n0 = 32 * nb;
#pragma unroll 8
    for (int i = 0; i < 32; ++i) { const int kk = 2 * i + (lane >> 5); scr[kk * 33 + (lane & 31)] = W[(size_t)(k0 + kk) * N + n0 + (lane & 31)]; }
    LDS_WAIT(); asm volatile("" ::: "memory");
    const int c = lane & 7; const int d0 = row_off + remap_col(mode, n0);
#pragma unroll
    for (int j = 0; j < 4; ++j) { const int n = (lane >> 3) + 8 * j; const LAS float* s = scr + (8 * c) * 33 + n;
        v4u o; o.x = pk2(s[0 * 33], s[1 * 33]); o.y = pk2(s[2 * 33], s[3 * 33]); o.z = pk2(s[4 * 33], s[5 * 33]); o.w = pk2(s[6 * 33], s[7 * 33]);
        *(GAS v4u*)(WT + (size_t)(d0 + n) * K + k0 + 8 * c) = o; }
    LDS_WAIT(); asm volatile("" ::: "memory");
}

__device__ __forceinline__ void ln_row(const float* src, const float* g, const float* b, bf16* obf, float* of32, float* st, int lane) {
    const f32x4* xr = (const f32x4*)src + lane;
    f32x4 v[4]; float s = 0.f;
#pragma unroll
    for (int j = 0; j < 4; ++j) { v[j] = xr[64 * j]; s += (v[j].x + v[j].y) + (v[j].z + v[j].w); }
    const float mean = wave_sum(s) * (1.f / 1024.f); float s2 = 0.f;
#pragma unroll
    for (int j = 0; j < 4; ++j) { v[j] = v[j] - mean; s2 += (v[j].x * v[j].x + v[j].y * v[j].y) + (v[j].z * v[j].z + v[j].w * v[j].w); }
    const float rstd = 1.f / sqrtf(wave_sum(s2) * (1.f / 1024.f) + LN_EPS);
    if (st && lane == 0) { st[0] = mean; st[1] = rstd; }
#pragma unroll
    for (int j = 0; j < 4; ++j) { const f32x4 gg = ((const f32x4*)g)[lane + 64 * j], bb = ((const f32x4*)b)[lane + 64 * j]; const f32x4 y = v[j] * rstd * gg + bb;
        if (obf) ((unsigned long long*)obf)[lane + 64 * j] = (unsigned long long)pk2(y.x, y.y) | ((unsigned long long)pk2(y.z, y.w) << 32);
        if (of32) ((f32x4*)of32)[lane + 64 * j] = y; }
}

__global__ void __launch_bounds__(NWAVES * 64, 2) mk_fwd(Args args) {
    extern __shared__ __attribute__((aligned(16))) unsigned char lds[];
    cg::grid_group grid = cg::this_grid();
    const int tid = threadIdx.x, lane = tid & 63, wave = __builtin_amdgcn_readfirstlane(tid >> 6);
    const int G = gridDim.x, bx = blockIdx.x;
    const int vcu = (G % 8 == 0) ? (bx % 8) * (G / 8) + bx / 8 : bx;
    const int gw = vcu * NWAVES + wave, NGW = G * NWAVES;
    unsigned char* ws = args.ws;
    const float* x = args.in[0]; const float* meta = args.in[1];
    float* stats0 = (float*)(ws + WS_STATS0); float* stats1 = (float*)(ws + WS_STATS1); float* rope = (float*)(ws + WS_ROPE);
    float* xmeta = (float*)(ws + WS_XMETA); float* ameta = (float*)(ws + WS_AMETA);
    bf16* WIN = (bf16*)(ws + WS_WIN); bf16* WPP = (bf16*)(ws + WS_WPP); bf16* WUQ = (bf16*)(ws + WS_WUQ); bf16* WUKV = (bf16*)(ws + WS_WUKV);
    bf16* PMLA = (bf16*)(ws + WS_PMLA); bf16* WOUT = (bf16*)(ws + WS_WOUT); bf16* WUP = (bf16*)(ws + WS_WUP); bf16* WDOWN = (bf16*)(ws + WS_WDOWN);
    bf16* BA = (bf16*)(ws + WS_A); bf16* GATE = (bf16*)(ws + WS_G); bf16* VP = (bf16*)(ws + WS_VP); bf16* LAT = (bf16*)(ws + WS_LAT);
    bf16* DP = (bf16*)(ws + WS_DP); bf16* CQN = (bf16*)(ws + WS_CQN); bf16* CKVN = (bf16*)(ws + WS_CKVN); bf16* KB = (bf16*)(ws + WS_KB); bf16* VB = (bf16*)(ws + WS_VB);
    bf16* HALO = (bf16*)(ws + WS_HALO); bf16* ACT = (bf16*)(ws + WS_ACT);
    bf16* QB = LAT; bf16* OB = VP;
    const int lo = args.ph_lo, hi = args.ph_hi;
#ifndef PHMASK
#define PHMASK 0xfff
#endif
#define IN(k) (((PHMASK >> (k)) & 1) && lo <= (k) && (k) < hi)
#define SEAM(k) do { if (IN(k) && IN((k) + 1)) grid.sync(); } while (0)
    LAS unsigned char* ldsl = (LAS unsigned char*)lds;

    if (IN(0)) {
        LAS float* scr = (LAS float*)(ldsl + wave * 16384);
        constexpr int I_IN = 16 * 101, I_UQ = 6 * 24, I_UK = 4 * 16, I_PM = 8 * 32, I_OUT = 16 * 32, I_UP = 16 * 176, I_DN = 44 * 32;
        constexpr int NITEMS = I_IN + I_UQ + 2 * I_UK + I_PM + I_OUT + I_UP + I_DN;
        for (int it = gw; it < NITEMS; it += NGW) {
            int r = it;
            if (r < I_UP) { p0_transpose_item(args.in[18], 1024, 5632, WUP, 0, 2, scr, r, lane); continue; } r -= I_UP;
            if (r < I_IN) { p0_transpose_item(args.in[4], 1024, 3232, WIN, 0, 1, scr, r, lane); continue; } r -= I_IN;
            if (r < I_DN) { p0_transpose_item(args.in[21], 2816, 1024, WDOWN, 0, 0, scr, r, lane); continue; } r -= I_DN;
            if (r < I_OUT) { p0_transpose_item(args.in[15], 1024, 1024, WOUT, 0, 0, scr, r, lane); continue; } r -= I_OUT;
            if (r < I_PM) { p0_transpose_item(args.in[13], 512, 1024, PMLA, 0, 0, scr, r, lane); continue; } r -= I_PM;
            if (r < I_UQ) { p0_transpose_item(args.in[9], 384, 768, WUQ, 0, 0, scr, r, lane); continue; } r -= I_UQ;
            if (r < I_UK) { p0_transpose_item(args.in[11], 256, 512, WUKV, 0, 0, scr, r, lane); continue; } r -= I_UK;
            p0_transpose_item(args.in[12], 256, 512, WUKV, 512, 0, scr, r, lane);
        }
        for (int i = gw * 64 + lane; i < 12288; i += NGW * 64) ((v4u*)(WIN + (size_t)3232 * 1024))[i] = (v4u){0u, 0u, 0u, 0u};
        for (int it = gw; it < 2048; it += NGW) {
            const int k = it >> 2, nq = it & 3, g = k >> 7;
            const float* pw = args.in[5] + (size_t)k * 128; const float* ps = args.in[6] + g * 128;
            const float* pp = args.in[7] + (size_t)(g * 128) * 1024 + nq * 256 + lane * 4;
            f32x4 a = (f32x4){0.f, 0.f, 0.f, 0.f};
#pragma unroll 8
            for (int d = 0; d < 128; ++d) { const float w = pw[d] * ps[d]; a += *(const f32x4*)(pp + (size_t)d * 1024) * w; }
            bf16* o = WPP + (size_t)(nq * 256 + lane * 4) * 512 + k;
            o[0] = (bf16)f2bf(a.x); o[512] = (bf16)f2bf(a.y); o[1024] = (bf16)f2bf(a.z); o[1536] = (bf16)f2bf(a.w);
        }
        for (int e = gw * 64 + lane; e < 4112 * 16; e += NGW * 64) {
            const int pos = e >> 4, i = e & 15, a4 = i >> 2, b4 = i & 3;
            double inv = b4 == 0 ? 1.0 : (b4 == 1 ? 0.5623413251903491 : (b4 == 2 ? 0.31622776601683794 : 0.1778279410038923));
            inv *= a4 == 0 ? 1.0 : (a4 == 1 ? 0.1 : (a4 == 2 ? 0.01 : 0.001));
            const float ang = (float)pos * (float)inv;
            const double t = (double)ang * 0.15915494309189535; const float fr_ = (float)(t - __builtin_rint(t));
            rope[2 * e] = __builtin_amdgcn_cosf(fr_); rope[2 * e + 1] = __builtin_amdgcn_sinf(fr_);
        }
        for (int row = gw; row < MP; row += NGW) {
            bf16* orow = BA + (size_t)row * 1024;
            if (row >= MR + 16) { ((unsigned long long*)orow)[lane] = 0ull; ((unsigned long long*)orow)[lane + 64] = 0ull; ((unsigned long long*)orow)[lane + 128] = 0ull; ((unsigned long long*)orow)[lane + 192] = 0ull;
                if (lane == 0) { stats0[2 * row] = 0.f; stats0[2 * row + 1] = 0.f; } continue; }
            const float* src = row < MR ? x + (size_t)row * 1024 : meta + (size_t)(row - MR) * 1024;
            ln_row(src, args.in[2], args.in[3], orow, nullptr, stats0 + 2 * row, lane);
        }
    }
    SEAM(0);

    if (IN(1)) {
        pg8::Gemm g{BA, WIN, MP, 3328, 1024}; pg8::StaticOrder S; S.init(MP, 3328, G, bx);
        pg8::EpiIn E{VP, GATE, LAT, args.in[14]};
        pg8::gemm_phase<pg8::EpiIn, pg8::StaticOrder, true, true>(ldsl, g, S, E);
    }
    SEAM(1);

    if (IN(2)) {
        for (int row = gw; row < MP; row += NGW) {
            v4u* dp = (v4u*)(DP + (size_t)row * 512) + lane;
            unsigned* cq = (unsigned*)(CQN + (size_t)row * 384) + lane; unsigned* ck = (unsigned*)(CKVN + (size_t)row * 256) + lane;
            v2u* kr = (v2u*)(KB + (size_t)row * 768 + (lane >> 3) * 96 + 64 + 4 * (lane & 7));
            if (row >= MR + 16) { *dp = (v4u){0u, 0u, 0u, 0u}; cq[0] = 0u; cq[64] = 0u; cq[128] = 0u; ck[0] = 0u; ck[64] = 0u; *kr = (v2u){0u, 0u}; continue; }
            const bool ismeta = row >= MR; const int s = ismeta ? row - MR : (row & 4095); const int pos = ismeta ? s : s + 16;
            { const int w = 2 << (lane >> 4);
              const v4u c = *((const v4u*)(VP + (size_t)row * 512) + lane);
              float sm[8] = {blo(c.x), bhi(c.x), blo(c.y), bhi(c.y), blo(c.z), bhi(c.z), blo(c.w), bhi(c.w)};
              float cur[8];
#pragma unroll
              for (int j = 0; j < 8; ++j) cur[j] = sm[j];
#pragma unroll
              for (int i = 1; i < 16; ++i) {
                  if (i < w && (!ismeta || s - i >= 0)) {
                      const int sr = (s - i >= 0) ? row - i : MR + 16 + (s - i);
                      const v4u q = *((const v4u*)(VP + (size_t)sr * 512) + lane);
                      sm[0] += blo(q.x); sm[1] += bhi(q.x); sm[2] += blo(q.y); sm[3] += bhi(q.y); sm[4] += blo(q.z); sm[5] += bhi(q.z); sm[6] += blo(q.w); sm[7] += bhi(q.w);
                  }
              }
              const int cnt = ismeta ? (s + 1 < w ? s + 1 : w) : w; const float ic = 1.0f / (float)cnt;
              v4u o; o.x = pk2(sm[0] * ic - cur[0], sm[1] * ic - cur[1]); o.y = pk2(sm[2] * ic - cur[2], sm[3] * ic - cur[3]);
              o.z = pk2(sm[4] * ic - cur[4], sm[5] * ic - cur[5]); o.w = pk2(sm[6] * ic - cur[6], sm[7] * ic - cur[7]);
              *dp = o; }
            { const unsigned* lq = (const unsigned*)(LAT + (size_t)row * 768) + lane;
              const unsigned q0 = lq[0], q1 = lq[64], q2 = lq[128], k0 = lq[192], k1 = lq[256];
              float ssq = blo(q0) * blo(q0) + bhi(q0) * bhi(q0) + blo(q1) * blo(q1) + bhi(q1) * bhi(q1) + blo(q2) * blo(q2) + bhi(q2) * bhi(q2);
              float ssk = blo(k0) * blo(k0) + bhi(k0) * bhi(k0) + blo(k1) * blo(k1) + bhi(k1) * bhi(k1);
              const float rq = QSCALE / sqrtf(wave_sum(ssq) * (1.f / 384.f) + LN_EPS), rk = 1.f / sqrtf(wave_sum(ssk) * (1.f / 256.f) + LN_EPS);
              const f32x2* gq = (const f32x2*)args.in[8] + lane; const f32x2* gk = (const f32x2*)args.in[10] + lane;
              cq[0] = pk2(blo(q0) * rq * gq[0].x, bhi(q0) * rq * gq[0].y); cq[64] = pk2(blo(q1) * rq * gq[64].x, bhi(q1) * rq * gq[64].y); cq[128] = pk2(blo(q2) * rq * gq[128].x, bhi(q2) * rq * gq[128].y);
              ck[0] = pk2(blo(k0) * rk * gk[0].x, bhi(k0) * rk * gk[0].y); ck[64] = pk2(blo(k1) * rk * gk[64].x, bhi(k1) * rk * gk[64].y); }
            { const bf16* lr = LAT + (size_t)row * 768 + 640; const int e = lane & 31, i = e & 15;
              const float x1 = __uint_as_float((unsigned)lr[i] << 16), x2 = __uint_as_float((unsigned)lr[i + 16] << 16);
              const float c = rope[((size_t)pos * 16 + i) * 2], sn = rope[((size_t)pos * 16 + i) * 2 + 1];
              const float val = e < 16 ? x1 * c - x2 * sn : x2 * c + x1 * sn;
              const int e0 = 4 * (lane & 7);
              const float v0 = __shfl(val, e0), v1 = __shfl(val, e0 + 1), v2 = __shfl(val, e0 + 2), v3 = __shfl(val, e0 + 3);
              *kr = (v2u){pk2(v0, v1), pk2(v2, v3)}; }
        }
    }
    SEAM(2);

    if (IN(3)) {
#ifndef PHSUB
#define PHSUB 3
#endif
        if (PHSUB & 1) { pg8::Gemm g{CQN, WUQ, MP, 768, 384}; pg8::StaticOrder S; S.init(MP, 768, G, bx);
          pg8::EpiKV E{QB, QB, 1};
          pg8::gemm_phase<pg8::EpiKV, pg8::StaticOrder, true, true>(ldsl, g, S, E); }
        if (PHSUB & 2) { pg8::Gemm g{CKVN, WUKV, MP, 1024, 256}; pg8::StaticOrder S; S.init(MP, 1024, G, bx);
          pg8::EpiKV E{KB, VB, 0};
          pg8::gemm_phase<pg8::EpiKV, pg8::StaticOrder, true, true>(ldsl, g, S, E); }
    }
    SEAM(3);

    if (IN(4)) {
        for (int u = vcu; u < 1032; u += G) {
            if (u < 1024) { const int i = u >> 8, v = u & 255, bh = v >> 2, s = v & 3; const int qb = (i == 0) ? s : (i == 1) ? 7 - s : (i == 2) ? 8 + s : 15 - s; const int b = bh >> 3, h = bh & 7;
                att::attn_unit((long)b * 4096 + qb * 256, (long)b * 4096, h, 4 * qb + 5, 4 * qb, (const att::bf16*)QB, (const att::bf16*)KB, (const att::bf16*)VB, (att::bf16*)OB, rope, (char*)lds); }
            else att::attn_unit(32768l, 0l, u - 1024, 1, -1, (const att::bf16*)QB, (const att::bf16*)KB, (const att::bf16*)VB, (att::bf16*)OB, rope, (char*)lds);
        }
    }
    SEAM(4);

    if (IN(5)) {
        { pg8::Gemm g{DP, WPP, MP, 1024, 512}; pg8::StaticOrder S; S.init(MP, 1024, G, bx);
          pg8::EpiMerge E{GATE, BA, 0};
          pg8::gemm_phase<pg8::EpiMerge, pg8::StaticOrder, true, true>(ldsl, g, S, E); }
        { pg8::Gemm g{OB, PMLA, MP, 1024, 512}; pg8::StaticOrder S; S.init(MP, 1024, G, bx);
          pg8::EpiMerge E{GATE, BA, 1};
          pg8::gemm_phase<pg8::EpiMerge, pg8::StaticOrder, true, true>(ldsl, g, S, E); }
    }
    SEAM(5);

    if (IN(6)) {
        pg8::Gemm g{BA, WOUT, MP, 1024, 1024}; pg8::StaticOrder S; S.init(MP, 1024, G, bx);
        pg8::EpiOut E{x, meta, stats0, args.in[2], args.in[3], args.out, xmeta, ALPHA};
        pg8::gemm_phase<pg8::EpiOut, pg8::StaticOrder, true, true>(ldsl, g, S, E);
    }
    SEAM(6);

    if (IN(7)) {
        for (int it = gw; it < 352; it += NGW) {
            const int cb = it >> 2, ks = it & 3; const int n = cb * 64 + lane;
            float hv[2][4];
#pragma unroll
            for (int j = 0; j < 2; ++j) {
                const float* src = xmeta + (size_t)(14 + j) * 1024;
                const f32x4* xr = (const f32x4*)src + lane; f32x4 v[4]; float s = 0.f;
#pragma unroll
                for (int q = 0; q < 4; ++q) { v[q] = xr[64 * q]; s += (v[q].x + v[q].y) + (v[q].z + v[q].w); }
                const float mean = wave_sum(s) * (1.f / 1024.f); float s2 = 0.f;
#pragma unroll
                for (int q = 0; q < 4; ++q) { v[q] = v[q] - mean; s2 += (v[q].x * v[q].x + v[q].y * v[q].y) + (v[q].z * v[q].z + v[q].w * v[q].w); }
                const float rstd = 1.f / sqrtf(wave_sum(s2) * (1.f / 1024.f) + LN_EPS);
#pragma unroll
                for (int q = 0; q < 4; ++q) { const int k = ks * 256 + q * 64 + lane; hv[j][q] = (src[k] - mean) * rstd * args.in[16][k] + args.in[17][k]; }
            }
            float a14 = 0.f, a15 = 0.f;
            const float* wp = args.in[18] + (size_t)(ks * 256) * 5632 + n;
#pragma unroll
            for (int q = 0; q < 4; ++q)
#pragma unroll 8
                for (int l = 0; l < 64; ++l) { const float w = wp[(size_t)(q * 64 + l) * 5632];
                    a14 += __shfl(hv[0][q], l) * w; a15 += __shfl(hv[1][q], l) * w; }
            ameta[(size_t)(ks * 2 + 0) * 5632 + n] = a14; ameta[(size_t)(ks * 2 + 1) * 5632 + n] = a15;
        }
        for (int row = gw; row < MR; row += NGW)
            ln_row(args.out + (size_t)row * 1024, args.in[16], args.in[17], BA + (size_t)row * 1024, nullptr, stats1 + 2 * row, lane);
    }
    SEAM(7);

    if (IN(8)) {
        pg8::Gemm g{BA, WUP, MR, 5632, 1024}; pg8::StaticOrder S; S.init(MR, 5632, G, bx);
        pg8::EpiUp E{args.in[19], args.in[20], ACT, HALO};
        pg8::gemm_phase<pg8::EpiUp, pg8::StaticOrder, true, true>(ldsl, g, S, E);
    }
    SEAM(8);

    if (IN(9)) {
        const float* cw = args.in[19]; const float* cb = args.in[20];
        for (int it = gw; it < 1024 * 44; it += NGW) {
            const int cbk = it % 44, ri = it / 44, g64 = ri >> 1, r = ri & 1;
            const int j = cbk * 64 + lane;
            const int dg = (j >> 7) * 256 + (j & 127), du = dg + 128;
            const int row = g64 * 64 + r; const int s = row & 4095;
            const bf16* hb = HALO + (size_t)g64 * 4 * 5632; const bf16* hp = hb - 4 * 5632;
            float a0g, a0u, a1g, a1u, a2g, a2u;
#define HL(p, slot, col) __uint_as_float((unsigned)(p)[(size_t)(slot) * 5632 + (col)] << 16)
#define AM(jr, col) (ameta[(size_t)(0 * 2 + (jr)) * 5632 + (col)] + ameta[(size_t)(1 * 2 + (jr)) * 5632 + (col)] + ameta[(size_t)(2 * 2 + (jr)) * 5632 + (col)] + ameta[(size_t)(3 * 2 + (jr)) * 5632 + (col)])
            a0g = HL(hb, r, dg); a0u = HL(hb, r, du);
            if (r == 0) {
                if (s == 0) { a1g = AM(1, j); a1u = AM(1, 2816 + j); a2g = AM(0, j); a2u = AM(0, 2816 + j); }
                else { a1g = HL(hp, 3, dg); a1u = HL(hp, 3, du); a2g = HL(hp, 2, dg); a2u = HL(hp, 2, du); }
            } else {
                a1g = HL(hb, 0, dg); a1u = HL(hb, 0, du);
                if (s == 1) { a2g = AM(1, j); a2u = AM(1, 2816 + j); }
                else { a2g = HL(hp, 3, dg); a2u = HL(hp, 3, du); }
            }
#undef HL
#undef AM
            const float cgv = cw[j] * a2g + cw[5632 + j] * a1g + cw[2 * 5632 + j] * a0g + cb[j];
            const float cuv = cw[2816 + j] * a2u + cw[5632 + 2816 + j] * a1u + cw[2 * 5632 + 2816 + j] * a0u + cb[2816 + j];
            const float a = cgv * pg8::sigm(cgv) * cuv;
            ACT[(size_t)row * 2816 + j] = (bf16)f2bf(a);
        }
    }
    SEAM(9);

    if (IN(10)) {
        pg8::Gemm g{ACT, WDOWN, MR, 1024, 2816}; pg8::StaticOrder S; S.init(MR, 1024, G, bx);
        pg8::EpiDown E{args.out, stats1, args.in[16], args.in[17], ALPHA};
        pg8::gemm_phase<pg8::EpiDown, pg8::StaticOrder, true, true>(ldsl, g, S, E);
    }
    SEAM(10);

    if (IN(11)) {
        for (int row = gw; row < MR; row += NGW)
            ln_row(args.out + (size_t)row * 1024, args.in[22], args.in[23], nullptr, args.out + (size_t)row * 1024, nullptr, lane);
    }
#undef IN
#undef SEAM
}

constexpr int LDS_BYTES = 147456;
constexpr int NPHASES = 12;
#ifndef MK_SPLIT
#define MK_SPLIT 0
#endif
extern "C" void kernel_launch(void* const* d_in, const int* in_sizes, int n_in, void* d_out, int out_size, void* d_ws, size_t ws_size, hipStream_t stream) {
    static int grid = 0;
    if (grid == 0) {
        if (n_in != 24 || out_size != MR * 1024 || ws_size < WS_END) { fprintf(stderr, "kernel_launch: unexpected shapes: n_in %d out %d ws %zu\n", n_in, out_size, ws_size); grid = -1; return; }
        int dev = 0, cus = 0, per_cu = 0;
        (void)hipGetDevice(&dev); (void)hipDeviceGetAttribute(&cus, hipDeviceAttributeMultiprocessorCount, dev);
        if (hipFuncSetAttribute((const void*)mk_fwd, hipFuncAttributeMaxDynamicSharedMemorySize, LDS_BYTES) != hipSuccess) { fprintf(stderr, "kernel_launch: hipFuncSetAttribute failed\n"); grid = -1; return; }
        if (hipOccupancyMaxActiveBlocksPerMultiprocessor(&per_cu, (const void*)mk_fwd, NWAVES * 64, LDS_BYTES) != hipSuccess || per_cu < 1) { fprintf(stderr, "kernel_launch: occupancy query says %d blocks per CU\n", per_cu); (void)hipGetLastError(); per_cu = 1; }
        grid = cus * 1;
        if (grid <= 0) grid = 256;
    }
    if (grid < 0) return;
    Args a{};
    for (int i = 0; i < 24; ++i) a.in[i] = (const float*)d_in[i];
    a.out = (float*)d_out; a.ws = (unsigned char*)d_ws;
#if MK_SPLIT
    for (int p = 0; p < NPHASES; ++p) { a.ph_lo = p; a.ph_hi = p + 1; hipLaunchKernelGGL(mk_fwd, dim3(grid), dim3(NWAVES * 64), LDS_BYTES, stream, a); }
#else
    a.ph_lo = 0; a.ph_hi = NPHASES;
    void* kargs[] = {&a};
    hipError_t e = hipLaunchCooperativeKernel((const void*)mk_fwd, dim3(grid), dim3(NWAVES * 64), kargs, LDS_BYTES, stream);
    if (e != hipSuccess) fprintf(stderr, "kernel_launch: cooperative launch failed: %s (grid %d)\n", hipGetErrorString(e), grid);
#endif
}
```

```cpp
#include <hip/hip_runtime.h>
#include <hip/hip_cooperative_groups.h>
#include <hip/hip_bf16.h>
#include <cstdio>
#include <cstdint>
#include <cmath>
namespace cg = cooperative_groups;
namespace pg8 {
#define PG8_LAS __attribute__((address_space(3)))
typedef unsigned short bf16_t;
typedef short bf16x8 __attribute__((ext_vector_type(8)));
typedef float f32x4 __attribute__((ext_vector_type(4)));
typedef unsigned u32x4 __attribute__((ext_vector_type(4)));
constexpr int BM = 256, BK = 64, HALF = 128, HTB = HALF * BK * 2  , STAGE_BYTES = 8 * HTB, NXCD = 8, WGM = 8;

__host__ __device__ __forceinline__ int lds_byte(int r, int c) { const int st = (r >> 4) * 2 + (c >> 5), rr = r & 15, cc = c & 31, ob = rr * 64 + cc * 2; return st * 1024 + (ob ^ (((ob >> 9) & 1) << 5)); }
__host__ __device__ __forceinline__ void stage_rc(int b, int& R, int& C) { const int st = b / 1024, sb = b % 1024, swz = sb ^ (((sb >> 9) & 1) << 5); R = (st >> 1) * 16 + swz / 64; C = (st & 1) * 32 + (swz % 64) / 2; }
__host__ __device__ __forceinline__ int perm32(int rho) { const int n = rho >> 4, i = rho & 15; return 8 * (i >> 2) + 4 * n + (i & 3); }

struct Unit { int pm, pn; };
struct Gemm { const bf16_t* A; const bf16_t* Bt; int M, N, K; };

struct StaticOrder {
    int nM, nN, nwg, G, c, cnt, rep;
    __host__ __device__ __forceinline__ void init(int M, int N, int G_, int c_, int rep_ = 1) { nM = M / BM; nN = N / BM; nwg = nM * nN; G = G_; c = c_; cnt = c < nwg ? (nwg - c + G - 1) / G : 0; rep = rep_; }
    __host__ __device__ __forceinline__ bool next(int i, Unit& u) const {
        if (i >= cnt) { i -= cnt; if (rep < 2 || i >= cnt) return false; }
        const long L = (long)i * G + c; if (L >= nwg) return false;
        int wgid = (int)L; { const int q = nwg / NXCD, r = nwg % NXCD, xcd = wgid % NXCD, off = wgid / NXCD; wgid = (xcd < r ? xcd * (q + 1) : r * (q + 1) + (xcd - r) * q) + off; }
        const int nig = WGM * nN, gid = wgid / nig, fm = gid * WGM, gsz = (nM - fm) < WGM ? (nM - fm) : WGM;
        u.pm = fm + ((wgid % nig) % gsz); u.pn = (wgid % nig) / gsz; return true;
    }
    __device__ __forceinline__ void a_ready(const Unit&) const {}
    __device__ __forceinline__ void done(const Unit&) const {}
};

__device__ __forceinline__ unsigned cvt_pk_bf16(float lo, float hi) { unsigned r; asm volatile("v_cvt_pk_bf16_f32 %0, %1, %2" : "=v"(r) : "v"(lo), "v"(hi)); return r; }
typedef float f32x2 __attribute__((ext_vector_type(2)));
__device__ __forceinline__ float bflo(unsigned w) { return __uint_as_float(w << 16); }
__device__ __forceinline__ float bfhi(unsigned w) { return __uint_as_float(w & 0xffff0000u); }
__device__ __forceinline__ float sigm(float x) { return __builtin_amdgcn_rcpf(1.0f + __builtin_amdgcn_exp2f(-1.4426950408889634f * x)); }
__device__ __forceinline__ u32x4 pack8(f32x4 a, f32x4 b) { u32x4 w; w.x = cvt_pk_bf16(a[0], a[1]); w.y = cvt_pk_bf16(a[2], a[3]); w.z = cvt_pk_bf16(b[0], b[1]); w.w = cvt_pk_bf16(b[2], b[3]); return w; }
typedef unsigned u32x2 __attribute__((ext_vector_type(2)));
__device__ __forceinline__ u32x2 pack4(f32x4 a) { u32x2 w; w.x = cvt_pk_bf16(a[0], a[1]); w.y = cvt_pk_bf16(a[2], a[3]); return w; }

struct EpiIn {
    static constexpr bool PERM = true, AFTER_DRAIN = false;
    bf16_t* VP; bf16_t* GATE; bf16_t* LAT; const float* bgate;
    __device__ __forceinline__ void operator()(const f32x4 (&acc)[2][2][4][2], const Unit& u, int wr, int wc, int fr, int fq) const {
        const int row0 = u.pm * BM + wr * 64 + fr;
        bf16_t* base; int ldc, colt; const float* bias = nullptr;
        if (u.pn < 2) { base = VP; ldc = 512; colt = u.pn * 256; }
        else if (u.pn < 10) { base = GATE; ldc = 2048; colt = (u.pn - 2) * 256; bias = bgate; }
        else { base = LAT; ldc = 768; colt = (u.pn - 10) * 256; }
        const int col0 = colt + wc * 32 + 8 * fq;
        f32x4 bv[2][2];
#pragma unroll
        for (int bj = 0; bj < 2; ++bj)
#pragma unroll
            for (int n = 0; n < 2; ++n) bv[bj][n] = bias ? *(const f32x4*)(bias + col0 + bj * HALF + 4 * n) : (f32x4){0.f, 0.f, 0.f, 0.f};
#pragma unroll
        for (int ai = 0; ai < 2; ++ai)
#pragma unroll
            for (int m = 0; m < 4; ++m) { bf16_t* rowp = base + (size_t)(row0 + ai * HALF + m * 16) * ldc + col0;
#pragma unroll
                for (int bj = 0; bj < 2; ++bj) { f32x4 v0 = acc[ai][bj][m][0] + bv[bj][0], v1 = acc[ai][bj][m][1] + bv[bj][1];
                    if (bias) {
#pragma unroll
                        for (int j = 0; j < 4; ++j) { v0[j] = sigm(v0[j]); v1[j] = sigm(v1[j]); } }
                    *(u32x4*)(rowp + bj * HALF) = pack8(v0, v1); } }
    }
};

struct EpiKV {
    static constexpr bool PERM = true, AFTER_DRAIN = false;
    bf16_t* KB; bf16_t* VB; int mode;
    __device__ __forceinline__ void operator()(const f32x4 (&acc)[2][2][4][2], const Unit& u, int wr, int wc, int fr, int fq) const {
        const int row0 = u.pm * BM + wr * 64 + fr;
#pragma unroll
        for (int ai = 0; ai < 2; ++ai)
#pragma unroll
            for (int m = 0; m < 4; ++m) { const size_t row = (size_t)(row0 + ai * HALF + m * 16);
#pragma unroll
                for (int bj = 0; bj < 2; ++bj) { const int c = u.pn * BM + bj * HALF + wc * 32 + 8 * fq;
                    bf16_t* p = mode ? KB + row * 768 + c : ((u.pn < 2) ? KB + row * 768 + (c >> 6) * 96 + (c & 63) : VB + row * 512 + (c - 512));
                    *(u32x4*)p = pack8(acc[ai][bj][m][0], acc[ai][bj][m][1]); } }
    }
};

struct EpiMerge {
    static constexpr bool PERM = true, AFTER_DRAIN = false;
    const bf16_t* GATE; bf16_t* T; int pass;
    __device__ __forceinline__ void operator()(const f32x4 (&acc)[2][2][4][2], const Unit& u, int wr, int wc, int fr, int fq) const {
        const int row0 = u.pm * BM + wr * 64 + fr;
#pragma unroll
        for (int ai = 0; ai < 2; ++ai)
#pragma unroll
            for (int m = 0; m < 4; ++m) { const size_t row = (size_t)(row0 + ai * HALF + m * 16);
#pragma unroll
                for (int bj = 0; bj < 2; ++bj) { const int c = u.pn * BM + bj * HALF + wc * 32 + 8 * fq;
                    const u32x4 g = *(const u32x4*)(GATE + row * 2048 + pass * 1024 + c);
                    f32x4 v0 = acc[ai][bj][m][0], v1 = acc[ai][bj][m][1];
                    v0 = v0 * (f32x4){bflo(g.x), bfhi(g.x), bflo(g.y), bfhi(g.y)}; v1 = v1 * (f32x4){bflo(g.z), bfhi(g.z), bflo(g.w), bfhi(g.w)};
                    bf16_t* p = T + row * 1024 + c;
                    if (pass) { const u32x4 t = *(const u32x4*)p; v0 = v0 + (f32x4){bflo(t.x), bfhi(t.x), bflo(t.y), bfhi(t.y)}; v1 = v1 + (f32x4){bflo(t.z), bfhi(t.z), bflo(t.w), bfhi(t.w)}; }
                    *(u32x4*)p = pack8(v0, v1); } }
    }
};

struct EpiOut {
    static constexpr bool PERM = true, AFTER_DRAIN = false;
    const float* x; const float* meta; const float* stats; const float* g; const float* b; float* out; float* xmeta; float alpha;
    __device__ __forceinline__ void operator()(const f32x4 (&acc)[2][2][4][2], const Unit& u, int wr, int wc, int fr, int fq) const {
        const int row0 = u.pm * BM + wr * 64 + fr;
#pragma unroll
        for (int bj = 0; bj < 2; ++bj) { const int c = u.pn * BM + bj * HALF + wc * 32 + 8 * fq;
            const f32x4 g0 = *(const f32x4*)(g + c), g1 = *(const f32x4*)(g + c + 4), b0 = *(const f32x4*)(b + c), b1 = *(const f32x4*)(b + c + 4);
#pragma unroll
            for (int ai = 0; ai < 2; ++ai)
#pragma unroll
                for (int m = 0; m < 4; ++m) { const int row = row0 + ai * HALF + m * 16;
                    const float* src; float* dst;
                    if (row < 32768) { src = x + (size_t)row * 1024 + c; dst = out + (size_t)row * 1024 + c; }
                    else { const int rr = row - 32768; src = rr < 16 ? meta + (size_t)rr * 1024 + c : nullptr; dst = xmeta + (size_t)rr * 1024 + c; }
                    f32x4 h0 = (f32x4){0.f, 0.f, 0.f, 0.f}, h1 = h0;
                    if (src) { const float mean = stats[2 * row], rstd = stats[2 * row + 1];
                        h0 = (*(const f32x4*)src - mean) * rstd * g0 + b0; h1 = (*(const f32x4*)(src + 4) - mean) * rstd * g1 + b1; }
                    *(f32x4*)dst = h0 * alpha + acc[ai][bj][m][0]; *(f32x4*)(dst + 4) = h1 * alpha + acc[ai][bj][m][1]; }
        }
    }
};

__device__ __forceinline__ float dpp_shr1(float cur, float prev) {
    const int t = __builtin_amdgcn_update_dpp(0, __float_as_int(prev), 0x121, 0xf, 0xf, false);
    return __int_as_float(__builtin_amdgcn_update_dpp(t, __float_as_int(cur), 0x111, 0xf, 0xf, false));
}
__device__ __forceinline__ float dpp_shr2(float cur, float prev) {
    const int t = __builtin_amdgcn_update_dpp(0, __float_as_int(prev), 0x122, 0xf, 0xf, false);
    return __int_as_float(__builtin_amdgcn_update_dpp(t, __float_as_int(cur), 0x112, 0xf, 0xf, false));
}
struct EpiUp {
    static constexpr bool PERM = false, AFTER_DRAIN = false;
    const float* cw; const float* cb; bf16_t* ACT; bf16_t* HALO;
    __device__ __forceinline__ void operator()(const f32x4 (&acc)[2][2][4][2], const Unit& u, int wr, int wc, int fr, int fq) const {
#pragma unroll
        for (int n = 0; n < 2; ++n) {
            const int jcol = u.pn * 128 + wc * 32 + 16 * n + 4 * fq;
            const int dcol = u.pn * 256 + wc * 32 + 16 * n + 4 * fq;
            const f32x4 wg0 = *(const f32x4*)(cw + jcol), wg1 = *(const f32x4*)(cw + 5632 + jcol), wg2 = *(const f32x4*)(cw + 2 * 5632 + jcol), bg = *(const f32x4*)(cb + jcol);
            const f32x4 wu0 = *(const f32x4*)(cw + 2816 + jcol), wu1 = *(const f32x4*)(cw + 5632 + 2816 + jcol), wu2 = *(const f32x4*)(cw + 2 * 5632 + 2816 + jcol), bu = *(const f32x4*)(cb + 2816 + jcol);
#pragma unroll
            for (int ai = 0; ai < 2; ++ai) {
                f32x4 pg = (f32x4){0.f, 0.f, 0.f, 0.f}, pu = pg;
#pragma unroll
                for (int m = 0; m < 4; ++m) {
                    const f32x4 ag = acc[ai][0][m][n], au = acc[ai][1][m][n];
                    f32x4 g1, g2, u1, u2;
#pragma unroll
                    for (int j = 0; j < 4; ++j) { g1[j] = dpp_shr1(ag[j], pg[j]); g2[j] = dpp_shr2(ag[j], pg[j]); u1[j] = dpp_shr1(au[j], pu[j]); u2[j] = dpp_shr2(au[j], pu[j]); }
                    const f32x4 cgv = wg2 * ag + wg1 * g1 + wg0 * g2 + bg, cuv = wu2 * au + wu1 * u1 + wu0 * u2 + bu;
                    f32x4 a;
#pragma unroll
                    for (int j = 0; j < 4; ++j) a[j] = cgv[j] * sigm(cgv[j]) * cuv[j];
                    const int row = u.pm * BM + ai * HALF + wr * 64 + m * 16 + fr;
                    if (!(m == 0 && fr < 2)) *(u32x2*)(ACT + (size_t)row * 2816 + jcol) = pack4(a);
                    if ((m == 0 && fr < 2) || (m == 3 && fr >= 14)) {
                        const int slot = (m == 0) ? fr : fr - 12, g64 = u.pm * 4 + ai * 2 + wr;
                        bf16_t* hp = HALO + ((size_t)g64 * 4 + slot) * 5632 + dcol;
                        *(u32x2*)hp = pack4(ag); *(u32x2*)(hp + 128) = pack4(au);
                    }
                    pg = ag; pu = au;
                }
            }
        }
    }
};

struct EpiDown {
    static constexpr bool PERM = true, AFTER_DRAIN = false;
    float* out; const float* stats; const float* g; const float* b; float alpha;
    __device__ __forceinline__ void operator()(const f32x4 (&acc)[2][2][4][2], const Unit& u, int wr, int wc, int fr, int fq) const {
        const int row0 = u.pm * BM + wr * 64 + fr;
#pragma unroll
        for (int bj = 0; bj < 2; ++bj) { const int c = u.pn * BM + bj * HALF + wc * 32 + 8 * fq;
            const f32x4 g0 = *(const f32x4*)(g + c), g1 = *(const f32x4*)(g + c + 4), b0 = *(const f32x4*)(b + c), b1 = *(const f32x4*)(b + c + 4);
#pragma unroll
            for (int ai = 0; ai < 2; ++ai)
#pragma unroll
                for (int m = 0; m < 4; ++m) { const int row = row0 + ai * HALF + m * 16;
                    float* p = out + (size_t)row * 1024 + c; const float mean = stats[2 * row], rstd = stats[2 * row + 1];
                    const f32x4 h0 = (*(const f32x4*)p - mean) * rstd * g0 + b0, h1 = (*(const f32x4*)(p + 4) - mean) * rstd * g1 + b1;
                    *(f32x4*)p = h0 * alpha + acc[ai][bj][m][0]; *(f32x4*)(p + 4) = h1 * alpha + acc[ai][bj][m][1]; }
        }
    }
};
template <class Epi, class Sched, bool ALIGN_EPI = false, bool SP2 = false>
__device__ __forceinline__ void gemm_phase(PG8_LAS unsigned char* lds, const Gemm g, const Sched& S, const Epi& E) {
    const int tid = threadIdx.x, wid = __builtin_amdgcn_readfirstlane(tid >> 6), lane = tid & 63, wr = wid >> 2, wc = wid & 3, fr = lane & 15, fq = lane >> 4;
    const int K = g.K, nt = K / BK;
    unsigned voffA[2], voffB[2];
#pragma unroll
    for (int i = 0; i < 2; ++i) { int R, C; stage_rc(tid * 16 + i * 8192, R, C); const int Rb = Epi::PERM ? ((R & ~31) + perm32(R & 31)) : R;
        voffA[i] = (unsigned)(R * K + C) * 2u; voffB[i] = (unsigned)(Rb * K + C) * 2u; }
    const size_t kstep = (size_t)(BK * 2);
    const size_t hstep = (size_t)HALF * K * 2;
    const size_t tstep = 2 * hstep;
    const unsigned ldsw = (unsigned)wid * 1024u;
    const int aoff = lds_byte(wr * 64 + fr, fq * 8), boff = lds_byte(wc * 32 + fr, fq * 8);
#define PG8_SA(b, h) (((b) * 2 + (h)) * HTB)
#define PG8_SB(b, h) ((4 + (b) * 2 + (h)) * HTB)
#define PG8_STAGE(bufoff, gbase, voff) do { _Pragma("unroll") for (int _i = 0; _i < 2; ++_i) \
        __builtin_amdgcn_global_load_lds((const unsigned*)((const char*)(gbase) + (voff)[_i]), (PG8_LAS unsigned*)(lds + (bufoff) + ldsw + _i * 8192), 16, 0, 0); } while (0)
#define PG8_LDA(dst, b, h) do { _Pragma("unroll") for (int m = 0; m < 4; ++m) _Pragma("unroll") for (int k = 0; k < 2; ++k) dst[m][k] = *(const PG8_LAS bf16x8*)(lds + PG8_SA(b, h) + aoff + m * 2048 + k * 1024); } while (0)
#define PG8_LDB(dst, b, h) do { _Pragma("unroll") for (int n = 0; n < 2; ++n) _Pragma("unroll") for (int k = 0; k < 2; ++k) dst[n][k] = *(const PG8_LAS bf16x8*)(lds + PG8_SB(b, h) + boff + n * 2048 + k * 1024); } while (0)
#define PG8_MMA(ai, bj, At, Bt) do { __builtin_amdgcn_s_setprio(1); _Pragma("unroll") for (int m = 0; m < 4; ++m) _Pragma("unroll") for (int n = 0; n < 2; ++n) _Pragma("unroll") for (int k = 0; k < 2; ++k) \
        acc[ai][bj][m][n] = __builtin_amdgcn_mfma_f32_16x16x32_bf16(Bt[n][k], At[m][k], acc[ai][bj][m][n], 0, 0, 0); __builtin_amdgcn_s_setprio(0); } while (0)
#define PG8_WAIT_V(n) asm volatile("s_waitcnt vmcnt(" #n ")" ::: "memory")
#define PG8_WAIT_L(n) asm volatile("s_waitcnt lgkmcnt(" #n ")" ::: "memory")
#define PG8_BAR __builtin_amdgcn_s_barrier()
#define PG8_SCHED __builtin_amdgcn_sched_barrier(0)
    Unit cur, nxt; int ui = 0;
    if (!S.next(0, cur)) return;
    f32x4 acc[2][2][4][2];
#pragma unroll
    for (int a = 0; a < 2; ++a)
#pragma unroll
        for (int b = 0; b < 2; ++b)
#pragma unroll
            for (int m = 0; m < 4; ++m)
#pragma unroll
                for (int n = 0; n < 2; ++n) acc[a][b][m][n] = (f32x4){0.f, 0.f, 0.f, 0.f};
    bf16x8 At[4][2], B0[2][2], B1[2][2];
    const char* cA = (const char*)g.A + (size_t)cur.pm * tstep; const char* cB = (const char*)g.Bt + (size_t)cur.pn * tstep;
    S.a_ready(cur);
    if constexpr (SP2) {
        PG8_STAGE(PG8_SB(0, 0), cB, voffB); PG8_STAGE(PG8_SB(0, 1), cB + hstep, voffB); PG8_STAGE(PG8_SA(0, 0), cA, voffA); PG8_STAGE(PG8_SA(0, 1), cA + hstep, voffA);
        if (wr == 1) PG8_BAR;
        PG8_WAIT_V(2); PG8_BAR;
        PG8_STAGE(PG8_SB(1, 0), cB + kstep, voffB); PG8_STAGE(PG8_SA(1, 0), cA + kstep, voffA); PG8_STAGE(PG8_SB(1, 1), cB + hstep + kstep, voffB);
        PG8_WAIT_V(6); PG8_BAR;
    } else {
        PG8_STAGE(PG8_SB(0, 0), cB, voffB); PG8_STAGE(PG8_SA(0, 0), cA, voffA); PG8_STAGE(PG8_SB(0, 1), cB + hstep, voffB); PG8_STAGE(PG8_SA(0, 1), cA + hstep, voffA);
        if (wr == 1) PG8_BAR;
        PG8_WAIT_V(4); PG8_BAR;
        PG8_STAGE(PG8_SB(1, 0), cB + kstep, voffB); PG8_STAGE(PG8_SA(1, 0), cA + kstep, voffA); PG8_STAGE(PG8_SB(1, 1), cB + hstep + kstep, voffB);
        PG8_WAIT_V(6); PG8_BAR;
    }
    for (;;) {
        const bool has_next = S.next(ui + 1, nxt);
        const char* nA = has_next ? (const char*)g.A + (size_t)nxt.pm * tstep : cA; const char* nB = has_next ? (const char*)g.Bt + (size_t)nxt.pn * tstep : cB;
        for (int t = 0; t < nt; t += 2) {
            const bool last = (t == nt - 2);
            const char* a1 = cA + (size_t)(t + 1) * kstep;
            const char* a2 = last ? nA : cA + (size_t)(t + 2) * kstep; const char* b2 = last ? nB : cB + (size_t)(t + 2) * kstep;
            const char* a3 = a2 + kstep; const char* b3 = b2 + kstep;
            if (last && has_next) S.a_ready(nxt);
            if constexpr (SP2) {
            PG8_LDB(B0, 0, 0); PG8_LDB(B1, 0, 1); PG8_SCHED; PG8_LDA(At, 0, 0); PG8_STAGE(PG8_SA(1, 1), a1 + hstep, voffA);
            PG8_WAIT_V(8); PG8_WAIT_L(0); PG8_BAR; PG8_MMA(0, 0, At, B0); PG8_MMA(0, 1, At, B1); PG8_BAR; PG8_SCHED;
            PG8_LDA(At, 0, 1); PG8_STAGE(PG8_SB(0, 0), b2, voffB); PG8_STAGE(PG8_SB(0, 1), b2 + hstep, voffB); PG8_STAGE(PG8_SA(0, 0), a2, voffA);
            PG8_WAIT_V(8); PG8_WAIT_L(0); PG8_BAR; PG8_MMA(1, 0, At, B0); PG8_MMA(1, 1, At, B1); PG8_BAR; PG8_SCHED;
            PG8_LDB(B0, 1, 0); PG8_LDB(B1, 1, 1); PG8_SCHED; PG8_LDA(At, 1, 0); PG8_STAGE(PG8_SA(0, 1), a2 + hstep, voffA);
            PG8_WAIT_V(8); PG8_WAIT_L(0); PG8_BAR; PG8_MMA(0, 0, At, B0); PG8_MMA(0, 1, At, B1); PG8_BAR; PG8_SCHED;
            PG8_LDA(At, 1, 1); PG8_STAGE(PG8_SB(1, 0), b3, voffB); PG8_STAGE(PG8_SB(1, 1), b3 + hstep, voffB); PG8_STAGE(PG8_SA(1, 0), a3, voffA);
            PG8_WAIT_V(8); PG8_WAIT_L(0); PG8_BAR; PG8_MMA(1, 0, At, B0); PG8_MMA(1, 1, At, B1); PG8_BAR; PG8_SCHED;
            } else {
            PG8_LDB(B0, 0, 0); PG8_SCHED; PG8_LDA(At, 0, 0); PG8_STAGE(PG8_SA(1, 1), a1 + hstep, voffA);
            PG8_WAIT_L(8); PG8_BAR; PG8_WAIT_L(0); PG8_MMA(0, 0, At, B0); PG8_BAR; PG8_SCHED;
            PG8_LDB(B1, 0, 1); PG8_STAGE(PG8_SB(0, 0), b2, voffB);
            PG8_BAR; PG8_WAIT_L(0); PG8_MMA(0, 1, At, B1); PG8_BAR;
            PG8_LDA(At, 0, 1); PG8_STAGE(PG8_SA(0, 0), a2, voffA);
            PG8_BAR; PG8_WAIT_L(0); PG8_MMA(1, 0, At, B0); PG8_BAR; PG8_SCHED;
            PG8_STAGE(PG8_SB(0, 1), b2 + hstep, voffB);
            PG8_WAIT_V(6); PG8_BAR; PG8_MMA(1, 1, At, B1); PG8_BAR;
            PG8_LDB(B0, 1, 0); PG8_SCHED; PG8_LDA(At, 1, 0); PG8_STAGE(PG8_SA(0, 1), a2 + hstep, voffA);
            PG8_WAIT_L(8); PG8_BAR; PG8_WAIT_L(0); PG8_MMA(0, 0, At, B0); PG8_BAR; PG8_SCHED;
            PG8_LDB(B1, 1, 1); PG8_STAGE(PG8_SB(1, 0), b3, voffB);
            PG8_BAR; PG8_WAIT_L(0); PG8_MMA(0, 1, At, B1); PG8_BAR;
            PG8_LDA(At, 1, 1); PG8_STAGE(PG8_SA(1, 0), a3, voffA);
            PG8_BAR; PG8_WAIT_L(0); PG8_MMA(1, 0, At, B0); PG8_BAR; PG8_SCHED;
            PG8_STAGE(PG8_SB(1, 1), b3 + hstep, voffB);
            PG8_WAIT_V(6); PG8_BAR; PG8_MMA(1, 1, At, B1); PG8_BAR;
            }
        }
        if constexpr (ALIGN_EPI) { if (wr == 0) PG8_BAR; }
        if constexpr (!Epi::AFTER_DRAIN) { E(acc, cur, wr, wc, fr, fq); S.done(cur); }
        if (!has_next) break;
#pragma unroll
        for (int a = 0; a < 2; ++a)
#pragma unroll
            for (int b = 0; b < 2; ++b)
#pragma unroll
                for (int m = 0; m < 4; ++m)
#pragma unroll
                    for (int n = 0; n < 2; ++n) acc[a][b][m][n] = (f32x4){0.f, 0.f, 0.f, 0.f};
        cur = nxt; cA = nA; cB = nB; ++ui;
        if constexpr (ALIGN_EPI) { if (wr == 1) PG8_BAR; }
    }
    PG8_WAIT_V(0);
    if constexpr (!ALIGN_EPI) { if (wr == 0) PG8_BAR; }
    PG8_BAR;
    if constexpr (Epi::AFTER_DRAIN) { E.fused(acc, cur, wr, wc, fr, fq, lds, wid, lane); S.done(cur); }
#undef PG8_SA
#undef PG8_SB
#undef PG8_STAGE
#undef PG8_LDA
#undef PG8_LDB
#undef PG8_MMA
#undef PG8_WAIT_V
#undef PG8_WAIT_L
#undef PG8_BAR
#undef PG8_SCHED
}
}
namespace att {
using bf16=__hip_bfloat16;
using bf16x8=__attribute__((ext_vector_type(8)))short;
using s16x4=__attribute__((ext_vector_type(4)))short;
using f32x16=__attribute__((ext_vector_type(16)))float;
using u32x4=__attribute__((ext_vector_type(4)))unsigned;
__device__ __forceinline__ int crow(int r,int hi){return (r&3)+8*(r>>2)+4*hi;}
#define SBAR() __builtin_amdgcn_sched_barrier(0)
__device__ __forceinline__ void glds16(const void*gsrc,unsigned lds_dst){unsigned keep;
  asm volatile("s_mov_b32 %0, m0\n\ts_mov_b32 m0, %2\n\ts_nop 0\n\tglobal_load_lds_dwordx4 %1, off\n\ts_mov_b32 m0, %0":"=&s"(keep):"v"(gsrc),"s"(lds_dst):"memory");}
__device__ __forceinline__ float max3f(float a,float b,float c){float r;asm("v_max3_f32 %0, %1, %2, %3":"=v"(r):"v"(a),"v"(b),"v"(c));return r;}
__device__ __forceinline__ float max2f(float a,float b){float r;asm("v_max_f32_e32 %0, %1, %2":"=v"(r):"v"(a),"v"(b));return r;}
__device__ __forceinline__ float fadd_s(float a,float b){float r;asm("v_add_f32_e32 %0, %1, %2":"=v"(r):"v"(a),"v"(b));return r;}
__device__ __forceinline__ float fsub_s(float a,float b){float r;asm("v_sub_f32_e32 %0, %1, %2":"=v"(r):"v"(a),"v"(b));return r;}
typedef float f32x2_t __attribute__((ext_vector_type(2))); typedef __bf16 bf16x2_t __attribute__((ext_vector_type(2)));
__device__ __forceinline__ unsigned cvtpk_s(float lo,float hi){f32x2_t v={lo,hi};bf16x2_t b=__builtin_convertvector(v,bf16x2_t);return __builtin_bit_cast(unsigned,b);}
typedef __attribute__((address_space(3))) const char* lds_cptr;
typedef short v4i16_t __attribute__((ext_vector_type(4)));
__device__ __forceinline__ float rowmax(const f32x16&p0,const f32x16&p1){
  float a=max3f(p0[0],p0[1],p1[0]),b=max3f(p0[2],p0[3],p1[1]);a=max3f(a,p1[2],p1[3]);
  #pragma unroll
  for(int r=4;r<16;r+=4){a=max3f(a,p0[r],p0[r+1]);b=max3f(b,p0[r+2],p0[r+3]);a=max3f(a,p1[r],p1[r+1]);b=max3f(b,p1[r+2],p1[r+3]);}
  const float m=max2f(a,b);
  auto rr=__builtin_amdgcn_permlane32_swap(__float_as_uint(m),__float_as_uint(m),false,false);
  return max2f(__uint_as_float(rr[0]),__uint_as_float(rr[1]));
}
__device__ __forceinline__ void pv(f32x16*o,int vb,bf16x8 pa0,bf16x8 pa1,bf16x8 pa2,bf16x8 pa3){
  #pragma unroll
  for(int d0=0;d0<2;++d0){s16x4 lo[4],hi[4];
    #pragma unroll
    for(int ks=0;ks<4;++ks){
      asm volatile("ds_read_b64_tr_b16 %0,%1 offset:%c2":"=&v"(lo[ks]):"v"(vb),"i"(d0*4096+ks*1024):"memory");
      asm volatile("ds_read_b64_tr_b16 %0,%1 offset:%c2":"=&v"(hi[ks]):"v"(vb),"i"(d0*4096+ks*1024+512):"memory");}
    asm volatile("s_waitcnt lgkmcnt(0)":::"memory");SBAR();
    #define PK(k) (bf16x8){lo[k][0],lo[k][1],lo[k][2],lo[k][3],hi[k][0],hi[k][1],hi[k][2],hi[k][3]}
    o[d0]=__builtin_amdgcn_mfma_f32_32x32x16_bf16(pa0,PK(0),o[d0],0,0,0);
    o[d0]=__builtin_amdgcn_mfma_f32_32x32x16_bf16(pa1,PK(1),o[d0],0,0,0);
    o[d0]=__builtin_amdgcn_mfma_f32_32x32x16_bf16(pa2,PK(2),o[d0],0,0,0);
    o[d0]=__builtin_amdgcn_mfma_f32_32x32x16_bf16(pa3,PK(3),o[d0],0,0,0);
    #undef PK
  }
}
constexpr int KSLOT = 12288, VSLOT = 8192;
constexpr int L_K = 0, L_V = 2 * KSLOT, L_WS = L_V + 2 * VSLOT, L_OST = L_WS + 8 * 64 * 4, L_BYTES = L_OST + 8 * 4096;
typedef __attribute__((address_space(3))) float* lds_fptr;
__device__ __forceinline__ void attn_unit(long qrow0, long kvrow0, int h, int NT, int qb4, const bf16* Q, const bf16* __restrict__ K, const bf16* __restrict__ V, bf16* O, const float* rope, char* shm) {
  const int tid = threadIdx.x, lane = tid & 63, r32 = lane & 31, hi = lane >> 5; const int wid = __builtin_amdgcn_readfirstlane(tid >> 6);
  const bf16* Qw = Q + (qrow0 + wid * 32) * 768 + h * 96;
  const unsigned lds0 = (unsigned)(uintptr_t)shm;
  const lds_cptr shm3 = (lds_cptr)shm;
  const lds_fptr wsf = (lds_fptr)(shm3 + L_WS) + wid * 64;
  const bf16* Kh = K + h * 96; const bf16* Vh = V + h * 64;
  const long koff = (long)lane * 768 + wid * 8;
  const long voff = (long)(16 * (wid & 3) + (lane >> 2)) * 512 + (wid >> 2) * 32 + (lane & 3) * 8;
#define ATT_DMA(t, slot) do { const long trow_ = ((t) == 0) ? 32768l : kvrow0 + (long)((t) - 1) * 64; \
    const bf16* kt_ = Kh + trow_ * 768 + koff; \
    glds16(kt_, (unsigned)__builtin_amdgcn_readfirstlane(lds0 + L_K + (slot) * KSLOT + wid * 1024)); \
    if (wid < 4) glds16(kt_ + 64, (unsigned)__builtin_amdgcn_readfirstlane(lds0 + L_K + (slot) * KSLOT + (8 + wid) * 1024)); \
    glds16(Vh + trow_ * 512 + voff, (unsigned)__builtin_amdgcn_readfirstlane(lds0 + L_V + (slot) * VSLOT + wid * 1024)); } while (0)
  ATT_DMA(0, 0);
  bf16x8 qr[6];
#pragma unroll
  for (int d0 = 0; d0 < 6; ++d0) qr[d0] = *reinterpret_cast<const bf16x8*>(&Qw[(long)r32 * 768 + d0 * 16 + hi * 8]);
  {
    const long qrow = qrow0 + wid * 32 + r32; const int pos = (qb4 < 0) ? (int)(qrow - 32768) : (int)(qrow & 4095) + 16;
    const float* rp = rope + ((size_t)pos * 16 + 8 * hi) * 2;
    bf16x8 a = qr[4], b = qr[5];
#pragma unroll
    for (int jj = 0; jj < 4; ++jj) { const __attribute__((ext_vector_type(4))) float cs = *(const __attribute__((ext_vector_type(4))) float*)(rp + 4 * jj);
#pragma unroll
      for (int e = 0; e < 2; ++e) { const int j = 2 * jj + e; const float c = cs[2 * e], sn = cs[2 * e + 1];
        const float x1 = __uint_as_float((unsigned)(unsigned short)a[j] << 16), x2 = __uint_as_float((unsigned)(unsigned short)b[j] << 16);
        const unsigned w = cvtpk_s(x1 * c - x2 * sn, x2 * c + x1 * sn);
        a[j] = (short)(w & 0xffffu); b[j] = (short)(w >> 16); } }
    qr[4] = a; qr[5] = b; }
  const int nvis = (qb4 < 0) ? 1 : 2 + qb4 + (wid >> 1);
  const int vb0 = (int)(lds0 + L_V) + ((lane >> 4) & 1) * 32 + (lane & 3) * 8 + (4 * hi + ((lane & 15) >> 2)) * 64;
  float m_run = -1e30f, l_run = 0.f; f32x16 o[2]; o[0] = f32x16{}; o[1] = f32x16{};
  for (int t = 0; t < NT; ++t) {
    asm volatile("s_waitcnt vmcnt(0) lgkmcnt(0)\n\ts_barrier" ::: "memory");
    if (t + 1 < NT) ATT_DMA(t + 1, (t + 1) & 1);
    if (t < nvis) {
      const int slot = t & 1;
      const lds_cptr kp = shm3 + L_K + slot * KSLOT + hi * 1024 + r32 * 16;
      f32x16 p0 = f32x16{}, p1 = f32x16{};
#pragma unroll
      for (int d0 = 0; d0 < 6; ++d0) {
        const bf16x8 b0 = *(const __attribute__((address_space(3))) bf16x8*)(kp + d0 * 2048);
        const bf16x8 b1 = *(const __attribute__((address_space(3))) bf16x8*)(kp + d0 * 2048 + 512);
        p0 = __builtin_amdgcn_mfma_f32_32x32x16_bf16(b0, qr[d0], p0, 0, 0, 0);
        p1 = __builtin_amdgcn_mfma_f32_32x32x16_bf16(b1, qr[d0], p1, 0, 0, 0);
      }
      if (t == 0) {
#pragma unroll
        for (int r = 0; r < 16; ++r) { if (r >= 8) p0[r] = -1e30f; p1[r] = -1e30f; }
      }
      const float rm = rowmax(p0, p1);
      const float m_new = fmaxf(m_run, rm);
      const float f = __builtin_amdgcn_exp2f(m_run - m_new);
      m_run = m_new;
      float sacc = 0.f;
#pragma unroll
      for (int r = 0; r < 16; ++r) { p0[r] = __builtin_amdgcn_exp2f(p0[r] - m_new); p1[r] = __builtin_amdgcn_exp2f(p1[r] - m_new); sacc += p0[r] + p1[r]; }
      l_run = l_run * f + sacc;
      if (hi == 0) wsf[r32] = f;
      asm volatile("s_waitcnt lgkmcnt(0)" ::: "memory");
#pragma unroll
      for (int r = 0; r < 16; ++r) { const float fr_ = wsf[crow(r, hi)]; o[0][r] *= fr_; o[1][r] *= fr_; }
      u32x4 pw0, pw1, pw2, pw3;
#define PKW(P, B) cvtpk_s(P[B], P[(B) + 1])
      pw0 = (u32x4){PKW(p0, 0), PKW(p0, 2), PKW(p0, 4), PKW(p0, 6)}; pw1 = (u32x4){PKW(p0, 8), PKW(p0, 10), PKW(p0, 12), PKW(p0, 14)};
      pw2 = (u32x4){PKW(p1, 0), PKW(p1, 2), PKW(p1, 4), PKW(p1, 6)}; pw3 = (u32x4){PKW(p1, 8), PKW(p1, 10), PKW(p1, 12), PKW(p1, 14)};
#undef PKW
      SBAR();
      pv(o, vb0 + slot * VSLOT, __builtin_bit_cast(bf16x8, pw0), __builtin_bit_cast(bf16x8, pw1), __builtin_bit_cast(bf16x8, pw2), __builtin_bit_cast(bf16x8, pw3));
    }
  }
#undef ATT_DMA
  { auto rr = __builtin_amdgcn_permlane32_swap(__float_as_uint(l_run), __float_as_uint(l_run), false, false); l_run = __uint_as_float(rr[0]) + __uint_as_float(rr[1]); }
  if (hi == 0) wsf[32 + r32] = l_run;
  asm volatile("s_waitcnt lgkmcnt(0)" ::: "memory");
  float rli[16];
#pragma unroll
  for (int r = 0; r < 16; ++r) rli[r] = __builtin_amdgcn_rcpf(wsf[32 + crow(r, hi)]);
  bf16* Ow = O + (qrow0 + wid * 32) * 512 + h * 64;
  { bf16* stg = (bf16*)(shm + L_OST) + wid * 2048;
#pragma unroll
    for (int r = 0; r < 16; ++r) { const int orow = crow(r, hi);
#pragma unroll
      for (int d0 = 0; d0 < 2; ++d0) stg[orow * 64 + d0 * 32 + r32] = __float2bfloat16(o[d0][r] * rli[r]); }
    asm volatile("s_waitcnt lgkmcnt(0)" ::: "memory");
#pragma unroll
    for (int i = 0; i < 4; ++i) { const int row = i * 8 + (lane >> 3), ch = lane & 7; const u32x4 v = *(const u32x4*)(stg + row * 64 + ch * 8); *(u32x4*)(Ow + (long)row * 512 + ch * 8) = v; } }
  asm volatile("s_waitcnt lgkmcnt(0)\n\ts_barrier" ::: "memory");
}
#undef SBAR
}
constexpr int NWAVES = 8;
constexpr int MR = 32768;
constexpr int MP = 33024;
constexpr int DMODEL = 1024, DPOOL = 512, QLORA = 384, KVLORA = 256, DFF = 2816;
constexpr float LN_EPS = 1e-6f;
constexpr float ALPHA = 1.189207115002721f;
constexpr float QSCALE = 0.10206207261596575f * 1.4426950408889634f;
constexpr size_t MiB = 1u << 20;
constexpr size_t WS_BAR = 896 * 1024;
constexpr size_t WS_STATS0 = 0, WS_STATS1 = 512 * 1024, WS_ROPE = 1 * MiB, WS_XMETA = 2 * MiB, WS_AMETA = 3 * MiB;
constexpr size_t WS_WIN = 4 * MiB, WS_WPP = WS_WIN + 13 * MiB / 2, WS_WUQ = WS_WPP + MiB, WS_WUKV = WS_WUQ + MiB, WS_PMLA = WS_WUKV + MiB / 2, WS_WOUT = WS_PMLA + MiB, WS_WUP = WS_WOUT + 2 * MiB, WS_WDOWN = WS_WUP + 11 * MiB;
static_assert(WS_WDOWN + 6 * MiB <= 36 * MiB, "weights");
constexpr size_t WS_A = 36 * MiB, WS_G = 101 * MiB, WS_VP = 231 * MiB, WS_LAT = 264 * MiB, WS_DP = 313 * MiB, WS_CQN = 346 * MiB, WS_CKVN = 371 * MiB, WS_KB = 388 * MiB, WS_VB = 437 * MiB, WS_HALO = 470 * MiB, WS_END = 493 * MiB;
constexpr size_t WS_ACT = WS_G;

#define GAS __attribute__((address_space(1)))
#define LAS __attribute__((address_space(3)))
typedef unsigned short bf16;
typedef unsigned v4u __attribute__((ext_vector_type(4)));
typedef unsigned v2u __attribute__((ext_vector_type(2)));
typedef float f32x4 __attribute__((ext_vector_type(4)));
typedef float f32x2 __attribute__((ext_vector_type(2)));
#define LDS_WAIT() asm volatile("s_waitcnt lgkmcnt(0)" ::: "memory")
__device__ __forceinline__ unsigned f2bf(float f) { unsigned u = __builtin_bit_cast(unsigned, f); return (u + 0x7fffu + ((u >> 16) & 1u)) >> 16; }
__device__ __forceinline__ unsigned pk2(float lo, float hi) { return f2bf(lo) | (f2bf(hi) << 16); }
__device__ __forceinline__ float blo(unsigned w) { return __uint_as_float(w << 16); }
__device__ __forceinline__ float bhi(unsigned w) { return __uint_as_float(w & 0xffff0000u); }
__device__ __forceinline__ float wave_sum(float v) {
#pragma unroll
    for (int o = 1; o < 64; o <<= 1) v += __shfl_xor(v, o);
    return v;
}

#define XB_TMO      128
#define XB_XCNT(j)  (256  + 64 * (j))
#define XB_XSUB(j)  (1280 + 64 * (j))
#define XB_XGEN(j)  (2304 + 64 * (j))
#define XB_TOP      3328
#define XB_TOPGEN   3392
#define XCD_BAR_WORDS 3456
#define XB_SPIN_CAP (1u << 18)

__device__ __forceinline__ unsigned xb_ld(unsigned* p)              { return __hip_atomic_load(p, __ATOMIC_RELAXED, __HIP_MEMORY_SCOPE_AGENT); }
__device__ __forceinline__ unsigned xb_add(unsigned* p, unsigned v) { return __hip_atomic_fetch_add(p, v, __ATOMIC_RELAXED, __HIP_MEMORY_SCOPE_AGENT); }
__device__ __forceinline__ unsigned xb_xcc_id() { return (unsigned)__builtin_amdgcn_s_getreg((3 << 11) | 20) & 0xFu; }
#define XB_SPIN(cond, bar) do { unsigned _sp = 0; while (cond) { __builtin_amdgcn_s_sleep(1); \
    if ((++_sp & 255u) == 0u) { if (xb_ld(&(bar)[XB_TMO])) break; if (_sp > XB_SPIN_CAP) { atomicAdd(&(bar)[XB_TMO], 1u); break; } } } } while (0)

struct XcdBarrier {
    unsigned* bar; unsigned x;
    volatile LAS unsigned* st;
};

__device__ __forceinline__ XcdBarrier xcd_barrier_post(unsigned* bar, volatile LAS unsigned* st) {
    XcdBarrier b; b.bar = bar; b.x = xb_xcc_id(); b.st = st;
    if (threadIdx.x == 0) (void)xb_add(&bar[XB_XCNT(b.x)], 1u);
    return b;
}
__device__ __forceinline__ void xcd_barrier_complete(unsigned* bar, unsigned x, unsigned& nloc, unsigned& nx) {
    const unsigned G = gridDim.x * gridDim.y * gridDim.z;
    unsigned sum, cnt, mine, sp = 0u;
    for (;;) {
        sum = 0u; cnt = 0u; mine = 0u;
#pragma unroll
        for (unsigned j = 0; j < 16; ++j) { const unsigned c = xb_ld(&bar[XB_XCNT(j)]); sum += c; cnt += (c > 0u) ? 1u : 0u; mine = (j == x) ? c : mine; }
        if (sum == G) break;
        __builtin_amdgcn_s_sleep(1);
        if ((++sp & 255u) == 0u) { if (xb_ld(&bar[XB_TMO])) break; if (sp > XB_SPIN_CAP) { atomicAdd(&bar[XB_TMO], 1u); break; } }
    }
    nloc = mine > 0u ? mine : 1u; nx = cnt > 0u ? cnt : 1u;
}

__device__ __forceinline__ void xcd_barrier(const XcdBarrier& b) {
    asm volatile("s_waitcnt vmcnt(0)" ::: "memory");
    __syncthreads();
    if (threadIdx.x == 0) {
        unsigned* bar = b.bar;
        __builtin_amdgcn_s_waitcnt(0);
        unsigned nloc = b.st[0], nx = b.st[1];
        if (nloc == 0u) { xcd_barrier_complete(bar, b.x, nloc, nx); b.st[0] = nloc; b.st[1] = nx; }
        const unsigned old = xb_add(&bar[XB_XSUB(b.x)], 1u);
        const unsigned gen = old / nloc;
        if (old + 1u == (gen + 1u) * nloc) {
            __builtin_amdgcn_fence(__ATOMIC_RELEASE, "agent");
            asm volatile("s_waitcnt vmcnt(0)" ::: "memory");
            const unsigned og = xb_add(&bar[XB_TOP], 1u);
            const unsigned tg = og / nx;
            if (og + 1u == (tg + 1u) * nx) xb_add(&bar[XB_TOPGEN], 1u);
            else XB_SPIN(xb_ld(&bar[XB_TOPGEN]) == tg, bar);
            __builtin_amdgcn_fence(__ATOMIC_ACQUIRE, "agent");
            xb_add(&bar[XB_XGEN(b.x)], 1u);
            asm volatile("s_waitcnt vmcnt(0)" ::: "memory");
        } else {
            XB_SPIN(xb_ld(&bar[XB_XGEN(b.x)]) == gen, bar);
            __builtin_amdgcn_fence(__ATOMIC_ACQUIRE, "agent");
            asm volatile("s_waitcnt vmcnt(0)" ::: "memory");
        }
    }
    __syncthreads();
}
struct Args { const float* in[24]; float* out; unsigned char* ws; int ph_lo, ph_hi; };

__device__ __forceinline__ int remap_col(int mode, int n0) {
    if (mode == 1) return n0 < 512 ? n0 : (n0 < 1184 ? n0 + 2048 : n0 - 672);
    if (mode == 2) { const int j = n0 < 2816 ? n0 : n0 - 2816; return (j >> 7) * 256 + (j & 127) + (n0 < 2816 ? 0 : 128); }
    return n0;
}
__device__ __forceinline__ void p0_transpose_item(const float* W, int K, int N, bf16* WT, int row_off, int mode, LAS float* scr, int item, int lane) {
    const int nblk = N / 32, kb = item / nblk, nb = item % nblk, k0 = 64 * kb, n0 = 32 * nb;
#pragma unroll 8
    for (int i = 0; i < 32; ++i) { const int kk = 2 * i + (lane >> 5); scr[kk * 33 + (lane & 31)] = W[(size_t)(k0 + kk) * N + n0 + (lane & 31)]; }
    LDS_WAIT(); asm volatile("" ::: "memory");
    const int c = lane & 7; const int d0 = row_off + remap_col(mode, n0);
#pragma unroll
    for (int j = 0; j < 4; ++j) { const int n = (lane >> 3) + 8 * j; const LAS float* s = scr + (8 * c) * 33 + n;
        v4u o; o.x = pk2(s[0 * 33], s[1 * 33]); o.y = pk2(s[2 * 33], s[3 * 33]); o.z = pk2(s[4 * 33], s[5 * 33]); o.w = pk2(s[6 * 33], s[7 * 33]);
        *(GAS v4u*)(WT + (size_t)(d0 + n) * K + k0 + 8 * c) = o; }
    LDS_WAIT(); asm volatile("" ::: "memory");
}

__device__ __forceinline__ void ln_row(const float* src, const float* g, const float* b, bf16* obf, float* of32, float* st, int lane) {
    const f32x4* xr = (const f32x4*)src + lane;
    f32x4 v[4]; float s = 0.f;
#pragma unroll
    for (int j = 0; j < 4; ++j) { v[j] = xr[64 * j]; s += (v[j].x + v[j].y) + (v[j].z + v[j].w); }
    const float mean = wave_sum(s) * (1.f / 1024.f); float s2 = 0.f;
#pragma unroll
    for (int j = 0; j < 4; ++j) { v[j] = v[j] - mean; s2 += (v[j].x * v[j].x + v[j].y * v[j].y) + (v[j].z * v[j].z + v[j].w * v[j].w); }
    const float rstd = 1.f / sqrtf(wave_sum(s2) * (1.f / 1024.f) + LN_EPS);
    if (st && lane == 0) { st[0] = mean; st[1] = rstd; }
#pragma unroll
    for (int j = 0; j < 4; ++j) { const f32x4 gg = ((const f32x4*)g)[lane + 64 * j], bb = ((const f32x4*)b)[lane + 64 * j]; const f32x4 y = v[j] * rstd * gg + bb;
        if (obf) ((unsigned long long*)obf)[lane + 64 * j] = (unsigned long long)pk2(y.x, y.y) | ((unsigned long long)pk2(y.z, y.w) << 32);
        if (of32) ((f32x4*)of32)[lane + 64 * j] = y; }
}

__device__ __forceinline__ void ln_row2(const float* s0, const float* s1, const float* g, const float* b, bf16* ob0, bf16* ob1, float* of0, float* of1, float* st0, float* st1, int lane) {
    const f32x4* x0 = (const f32x4*)s0 + lane; const f32x4* x1 = (const f32x4*)s1 + lane;
    f32x4 v[4], w[4]; float sa = 0.f, sb = 0.f;
#pragma unroll
    for (int j = 0; j < 4; ++j) { v[j] = x0[64 * j]; w[j] = x1[64 * j]; }
#pragma unroll
    for (int j = 0; j < 4; ++j) { sa += (v[j].x + v[j].y) + (v[j].z + v[j].w); sb += (w[j].x + w[j].y) + (w[j].z + w[j].w); }
    const float ma = wave_sum(sa) * (1.f / 1024.f), mb = wave_sum(sb) * (1.f / 1024.f); float qa = 0.f, qb = 0.f;
#pragma unroll
    for (int j = 0; j < 4; ++j) { v[j] = v[j] - ma; w[j] = w[j] - mb; qa += (v[j].x * v[j].x + v[j].y * v[j].y) + (v[j].z * v[j].z + v[j].w * v[j].w); qb += (w[j].x * w[j].x + w[j].y * w[j].y) + (w[j].z * w[j].z + w[j].w * w[j].w); }
    const float ra = 1.f / sqrtf(wave_sum(qa) * (1.f / 1024.f) + LN_EPS), rb = 1.f / sqrtf(wave_sum(qb) * (1.f / 1024.f) + LN_EPS);
    if (st0 && lane == 0) { st0[0] = ma; st0[1] = ra; st1[0] = mb; st1[1] = rb; }
#pragma unroll
    for (int j = 0; j < 4; ++j) { const f32x4 gg = ((const f32x4*)g)[lane + 64 * j], bb = ((const f32x4*)b)[lane + 64 * j]; const f32x4 y = v[j] * ra * gg + bb, z = w[j] * rb * gg + bb;
        if (ob0) { ((unsigned long long*)ob0)[lane + 64 * j] = (unsigned long long)pk2(y.x, y.y) | ((unsigned long long)pk2(y.z, y.w) << 32);
                   ((unsigned long long*)ob1)[lane + 64 * j] = (unsigned long long)pk2(z.x, z.y) | ((unsigned long long)pk2(z.z, z.w) << 32); }
        if (of0) { ((f32x4*)of0)[lane + 64 * j] = y; ((f32x4*)of1)[lane + 64 * j] = z; } }
}

__global__ void __launch_bounds__(NWAVES * 64, 2) mk_fwd(Args args) {
    extern __shared__ __attribute__((aligned(16))) unsigned char lds[];
    cg::grid_group grid = cg::this_grid();
    const int tid = threadIdx.x, lane = tid & 63, wave = __builtin_amdgcn_readfirstlane(tid >> 6);
    const int G = gridDim.x, bx = blockIdx.x;
    const int vcu = (G % 8 == 0) ? (bx % 8) * (G / 8) + bx / 8 : bx;
    const int gw = vcu * NWAVES + wave, NGW = G * NWAVES;
    unsigned char* ws = args.ws;
#define XIN (args.in[0])
#define METAIN (args.in[1])
#define stats0 ((float*)(ws + WS_STATS0))
#define stats1 ((float*)(ws + WS_STATS1))
#define rope ((float*)(ws + WS_ROPE))
#define xmeta ((float*)(ws + WS_XMETA))
#define ameta ((float*)(ws + WS_AMETA))
#define WIN ((bf16*)(ws + WS_WIN))
#define WPP ((bf16*)(ws + WS_WPP))
#define WUQ ((bf16*)(ws + WS_WUQ))
#define WUKV ((bf16*)(ws + WS_WUKV))
#define PMLA ((bf16*)(ws + WS_PMLA))
#define WOUT ((bf16*)(ws + WS_WOUT))
#define WUP ((bf16*)(ws + WS_WUP))
#define WDOWN ((bf16*)(ws + WS_WDOWN))
#define BA ((bf16*)(ws + WS_A))
#define GATE ((bf16*)(ws + WS_G))
#define VP ((bf16*)(ws + WS_VP))
#define LAT ((bf16*)(ws + WS_LAT))
#define DP ((bf16*)(ws + WS_DP))
#define CQN ((bf16*)(ws + WS_CQN))
#define CKVN ((bf16*)(ws + WS_CKVN))
#define KB ((bf16*)(ws + WS_KB))
#define VB ((bf16*)(ws + WS_VB))
#define HALO ((bf16*)(ws + WS_HALO))
#define ACT ((bf16*)(ws + WS_ACT))
#define QB LAT
#define OB VP
    const int lo = args.ph_lo, hi = args.ph_hi;
#ifndef PHMASK
#define PHMASK 0xfff
#endif
#define IN(k) (((PHMASK >> (k)) & 1) && lo <= (k) && (k) < hi)
#ifndef DUPMASK
#define DUPMASK 0
#endif
#ifndef XSYNC
#define XSYNC 0
#endif
#define REP(k) for (int rep_ = 0; rep_ < 1 + ((DUPMASK >> (k)) & 1); ++rep_)
#define SEAM(k) do { if (IN(k) && IN((k) + 1)) xcd_barrier(bar); } while (0)
    LAS unsigned char* ldsl = (LAS unsigned char*)lds;
    if (tid < 16) ((volatile LAS unsigned*)(ldsl + 131072 + 64))[tid] = 0u;
    if (bx == 0) for (int i = tid; i < XCD_BAR_WORDS; i += NWAVES * 64) __hip_atomic_store((unsigned*)(ws + WS_BAR) + i, 0u, __ATOMIC_RELAXED, __HIP_MEMORY_SCOPE_AGENT);
    __syncthreads();

    if (IN(0)) REP(0) {
        LAS float* scr = (LAS float*)(ldsl + wave * 16384);
        constexpr int I_IN = 16 * 101, I_UQ = 6 * 24, I_UK = 4 * 16, I_PM = 8 * 32, I_OUT = 16 * 32, I_UP = 16 * 176, I_DN = 44 * 32;
        constexpr int NITEMS = I_IN + I_UQ + 2 * I_UK + I_PM + I_OUT + I_UP + I_DN;
        for (int it = gw; it < NITEMS; it += NGW) {
            int r = it;
            if (r < I_UP) { p0_transpose_item(args.in[18], 1024, 5632, WUP, 0, 2, scr, r, lane); continue; } r -= I_UP;
            if (r < I_IN) { p0_transpose_item(args.in[4], 1024, 3232, WIN, 0, 1, scr, r, lane); continue; } r -= I_IN;
            if (r < I_DN) { p0_transpose_item(args.in[21], 2816, 1024, WDOWN, 0, 0, scr, r, lane); continue; } r -= I_DN;
            if (r < I_OUT) { p0_transpose_item(args.in[15], 1024, 1024, WOUT, 0, 0, scr, r, lane); continue; } r -= I_OUT;
            if (r < I_PM) { p0_transpose_item(args.in[13], 512, 1024, PMLA, 0, 0, scr, r, lane); continue; } r -= I_PM;
            if (r < I_UQ) { p0_transpose_item(args.in[9], 384, 768, WUQ, 0, 0, scr, r, lane); continue; } r -= I_UQ;
            if (r < I_UK) { p0_transpose_item(args.in[11], 256, 512, WUKV, 0, 0, scr, r, lane); continue; } r -= I_UK;
            p0_transpose_item(args.in[12], 256, 512, WUKV, 512, 0, scr, r, lane);
        }
        for (int i = gw * 64 + lane; i < 12288; i += NGW * 64) ((v4u*)(WIN + (size_t)3232 * 1024))[i] = (v4u){0u, 0u, 0u, 0u};
        for (int it = gw; it < 2048; it += NGW) {
            const int k = it >> 2, nq = it & 3, g = k >> 7;
            const float* pw = args.in[5] + (size_t)k * 128; const float* ps = args.in[6] + g * 128;
            const float* pp = args.in[7] + (size_t)(g * 128) * 1024 + nq * 256 + lane * 4;
            f32x4 a = (f32x4){0.f, 0.f, 0.f, 0.f};
#pragma unroll 32
            for (int d = 0; d < 128; ++d) { const float w = pw[d] * ps[d]; a += *(const f32x4*)(pp + (size_t)d * 1024) * w; }
            bf16* o = WPP + (size_t)(nq * 256 + lane * 4) * 512 + k;
            o[0] = (bf16)f2bf(a.x); o[512] = (bf16)f2bf(a.y); o[1024] = (bf16)f2bf(a.z); o[1536] = (bf16)f2bf(a.w);
        }
        for (int e = gw * 64 + lane; e < 4112 * 16; e += NGW * 64) {
            const int pos = e >> 4, i = e & 15, a4 = i >> 2, b4 = i & 3;
            double inv = b4 == 0 ? 1.0 : (b4 == 1 ? 0.5623413251903491 : (b4 == 2 ? 0.31622776601683794 : 0.1778279410038923));
            inv *= a4 == 0 ? 1.0 : (a4 == 1 ? 0.1 : (a4 == 2 ? 0.01 : 0.001));
            const float ang = (float)pos * (float)inv;
            const double t = (double)ang * 0.15915494309189535; const float fr_ = (float)(t - __builtin_rint(t));
            rope[2 * e] = __builtin_amdgcn_cosf(fr_); rope[2 * e + 1] = __builtin_amdgcn_sinf(fr_);
        }
        for (int row = gw; row < MR + 16; row += 2 * NGW) {
            const int r1 = row + NGW < MR + 16 ? row + NGW : row;
            const float* s0 = row < MR ? XIN + (size_t)row * 1024 : METAIN + (size_t)(row - MR) * 1024;
            const float* s1 = r1 < MR ? XIN + (size_t)r1 * 1024 : METAIN + (size_t)(r1 - MR) * 1024;
            ln_row2(s0, s1, args.in[2], args.in[3], BA + (size_t)row * 1024, BA + (size_t)r1 * 1024, nullptr, nullptr, stats0 + 2 * row, stats0 + 2 * r1, lane);
        }
        for (int row = MR + 16 + gw; row < MP; row += NGW) {
            unsigned long long* orow = (unsigned long long*)(BA + (size_t)row * 1024);
            orow[lane] = 0ull; orow[lane + 64] = 0ull; orow[lane + 128] = 0ull; orow[lane + 192] = 0ull;
            if (lane == 0) { stats0[2 * row] = 0.f; stats0[2 * row + 1] = 0.f; }
        }
    }
    XcdBarrier bar; bar.bar = (unsigned*)(ws + WS_BAR); bar.x = 0; bar.st = (volatile LAS unsigned*)(ldsl + 131072 + 64);
    if (IN(0) && IN(1)) { grid.sync(); bar = xcd_barrier_post((unsigned*)(ws + WS_BAR), (volatile LAS unsigned*)(ldsl + 131072 + 64)); }
    for (int xs_ = 0; xs_ < XSYNC; ++xs_) xcd_barrier(bar);

    if (IN(1)) {
        pg8::Gemm g{BA, WIN, MP, 3328, 1024}; pg8::StaticOrder S; S.init(MP, 3328, G, bx, 1 + ((DUPMASK >> 1) & 1));
        pg8::EpiIn E{VP, GATE, LAT, args.in[14]};
        pg8::gemm_phase<pg8::EpiIn, pg8::StaticOrder, true, true>(ldsl, g, S, E);
    }
    SEAM(1);

    if (IN(2)) REP(2) {
        for (int row = gw; row < MP; row += NGW) {
            v4u* dp = (v4u*)(DP + (size_t)row * 512) + lane;
            unsigned* cq = (unsigned*)(CQN + (size_t)row * 384) + lane; unsigned* ck = (unsigned*)(CKVN + (size_t)row * 256) + lane;
            v2u* kr = (v2u*)(KB + (size_t)row * 768 + (lane >> 3) * 96 + 64 + 4 * (lane & 7));
            if (row >= MR + 16) { *dp = (v4u){0u, 0u, 0u, 0u}; cq[0] = 0u; cq[64] = 0u; cq[128] = 0u; ck[0] = 0u; ck[64] = 0u; *kr = (v2u){0u, 0u}; continue; }
            const bool ismeta = row >= MR; const int s = ismeta ? row - MR : (row & 4095); const int pos = ismeta ? s : s + 16;
            { const int w = 2 << (lane >> 4);
              const v4u c = *((const v4u*)(VP + (size_t)row * 512) + lane);
              float sm[8] = {blo(c.x), bhi(c.x), blo(c.y), bhi(c.y), blo(c.z), bhi(c.z), blo(c.w), bhi(c.w)};
              float cur[8];
#pragma unroll
              for (int j = 0; j < 8; ++j) cur[j] = sm[j];
#pragma unroll
              for (int i = 1; i < 16; ++i) {
                  const bool ok = i < w && (!ismeta || s - i >= 0);
                  const int sr = !ok ? row : ((s - i >= 0) ? row - i : MR + 16 + (s - i));
                  v4u q = *((const v4u*)(VP + (size_t)sr * 512) + lane);
                  if (!ok) q = (v4u){0u, 0u, 0u, 0u};
                  sm[0] += blo(q.x); sm[1] += bhi(q.x); sm[2] += blo(q.y); sm[3] += bhi(q.y); sm[4] += blo(q.z); sm[5] += bhi(q.z); sm[6] += blo(q.w); sm[7] += bhi(q.w);
              }
              const int cnt = ismeta ? (s + 1 < w ? s + 1 : w) : w; const float ic = 1.0f / (float)cnt;
              v4u o; o.x = pk2(sm[0] * ic - cur[0], sm[1] * ic - cur[1]); o.y = pk2(sm[2] * ic - cur[2], sm[3] * ic - cur[3]);
              o.z = pk2(sm[4] * ic - cur[4], sm[5] * ic - cur[5]); o.w = pk2(sm[6] * ic - cur[6], sm[7] * ic - cur[7]);
              *dp = o; }
            { const unsigned* lq = (const unsigned*)(LAT + (size_t)row * 768) + lane;
              const unsigned q0 = lq[0], q1 = lq[64], q2 = lq[128], k0 = lq[192], k1 = lq[256];
              float ssq = blo(q0) * blo(q0) + bhi(q0) * bhi(q0) + blo(q1) * blo(q1) + bhi(q1) * bhi(q1) + blo(q2) * blo(q2) + bhi(q2) * bhi(q2);
              float ssk = blo(k0) * blo(k0) + bhi(k0) * bhi(k0) + blo(k1) * blo(k1) + bhi(k1) * bhi(k1);
              const float rq = QSCALE / sqrtf(wave_sum(ssq) * (1.f / 384.f) + LN_EPS), rk = 1.f / sqrtf(wave_sum(ssk) * (1.f / 256.f) + LN_EPS);
              const f32x2* gq = (const f32x2*)args.in[8] + lane; const f32x2* gk = (const f32x2*)args.in[10] + lane;
              cq[0] = pk2(blo(q0) * rq * gq[0].x, bhi(q0) * rq * gq[0].y); cq[64] = pk2(blo(q1) * rq * gq[64].x, bhi(q1) * rq * gq[64].y); cq[128] = pk2(blo(q2) * rq * gq[128].x, bhi(q2) * rq * gq[128].y);
              ck[0] = pk2(blo(k0) * rk * gk[0].x, bhi(k0) * rk * gk[0].y); ck[64] = pk2(blo(k1) * rk * gk[64].x, bhi(k1) * rk * gk[64].y); }
            { const bf16* lr = LAT + (size_t)row * 768 + 640; const int e = lane & 31, i = e & 15;
              const float x1 = __uint_as_float((unsigned)lr[i] << 16), x2 = __uint_as_float((unsigned)lr[i + 16] << 16);
              const float c = rope[((size_t)pos * 16 + i) * 2], sn = rope[((size_t)pos * 16 + i) * 2 + 1];
              const float val = e < 16 ? x1 * c - x2 * sn : x2 * c + x1 * sn;
              const int e0 = 4 * (lane & 7);
              const float v0 = __shfl(val, e0), v1 = __shfl(val, e0 + 1), v2 = __shfl(val, e0 + 2), v3 = __shfl(val, e0 + 3);
              *kr = (v2u){pk2(v0, v1), pk2(v2, v3)}; }
        }
    }
    SEAM(2);

    if (IN(3)) {
#ifndef PHSUB
#define PHSUB 3
#endif
        if (PHSUB & 1) { pg8::Gemm g{CQN, WUQ, MP, 768, 384}; pg8::StaticOrder S; S.init(MP, 768, G, bx, 1 + ((DUPMASK >> 3) & 1));
          pg8::EpiKV E{QB, QB, 1};
          pg8::gemm_phase<pg8::EpiKV, pg8::StaticOrder, true, true>(ldsl, g, S, E); }
        if (PHSUB & 2) { pg8::Gemm g{CKVN, WUKV, MP, 1024, 256}; pg8::StaticOrder S; S.init(MP, 1024, G, bx, 1 + ((DUPMASK >> 3) & 1));
          pg8::EpiKV E{KB, VB, 0};
          pg8::gemm_phase<pg8::EpiKV, pg8::StaticOrder, true, true>(ldsl, g, S, E); }
    }
    SEAM(3);

    if (IN(4)) REP(4) {
        for (int u = vcu; u < 1032; u += G) {
            if (u < 1024) { const int i = u >> 8, v = u & 255, bh = v >> 2, s = v & 3; const int qb = (i == 0) ? s : (i == 1) ? 7 - s : (i == 2) ? 8 + s : 15 - s; const int b = bh >> 3, h = bh & 7;
                att::attn_unit((long)b * 4096 + qb * 256, (long)b * 4096, h, 4 * qb + 5, 4 * qb, (const att::bf16*)QB, (const att::bf16*)KB, (const att::bf16*)VB, (att::bf16*)OB, rope, (char*)lds); }
            else att::attn_unit(32768l, 0l, u - 1024, 1, -1, (const att::bf16*)QB, (const att::bf16*)KB, (const att::bf16*)VB, (att::bf16*)OB, rope, (char*)lds);
        }
    }
    SEAM(4);

    if (IN(5)) {
        { pg8::Gemm g{DP, WPP, MP, 1024, 512}; pg8::StaticOrder S; S.init(MP, 1024, G, bx, 1 + ((DUPMASK >> 5) & 1));
          pg8::EpiMerge E{GATE, BA, 0};
          pg8::gemm_phase<pg8::EpiMerge, pg8::StaticOrder, true, true>(ldsl, g, S, E); }
        { pg8::Gemm g{OB, PMLA, MP, 1024, 512}; pg8::StaticOrder S; S.init(MP, 1024, G, bx);
          pg8::EpiMerge E{GATE, BA, 1};
          pg8::gemm_phase<pg8::EpiMerge, pg8::StaticOrder, true, true>(ldsl, g, S, E); }
    }
    SEAM(5);

    if (IN(6)) {
        pg8::Gemm g{BA, WOUT, MP, 1024, 1024}; pg8::StaticOrder S; S.init(MP, 1024, G, bx, 1 + ((DUPMASK >> 6) & 1));
        pg8::EpiOut E{XIN, METAIN, stats0, args.in[2], args.in[3], args.out, xmeta, ALPHA};
        pg8::gemm_phase<pg8::EpiOut, pg8::StaticOrder, true, true>(ldsl, g, S, E);
    }
    SEAM(6);

    if (IN(7)) REP(7) {
        for (int it = gw; it < 1408; it += NGW) {
            const int cb = it >> 4, ks = it & 15; const int n = cb * 64 + lane;
            float hv[2];
#pragma unroll
            for (int j = 0; j < 2; ++j) {
                const float* src = xmeta + (size_t)(14 + j) * 1024;
                const f32x4* xr = (const f32x4*)src + lane; f32x4 v[4]; float sacc = 0.f;
#pragma unroll
                for (int q = 0; q < 4; ++q) { v[q] = xr[64 * q]; sacc += (v[q].x + v[q].y) + (v[q].z + v[q].w); }
                const float mean = wave_sum(sacc) * (1.f / 1024.f); float s2 = 0.f;
#pragma unroll
                for (int q = 0; q < 4; ++q) { v[q] = v[q] - mean; s2 += (v[q].x * v[q].x + v[q].y * v[q].y) + (v[q].z * v[q].z + v[q].w * v[q].w); }
                const float rstd = 1.f / sqrtf(wave_sum(s2) * (1.f / 1024.f) + LN_EPS);
                const int k = ks * 64 + lane; hv[j] = (src[k] - mean) * rstd * args.in[16][k] + args.in[17][k];
            }
            float a14 = 0.f, a15 = 0.f;
            const float* wp = args.in[18] + (size_t)(ks * 64) * 5632 + n;
#pragma unroll
            for (int l = 0; l < 64; ++l) { const float w = wp[(size_t)l * 5632]; a14 += __shfl(hv[0], l) * w; a15 += __shfl(hv[1], l) * w; }
            ameta[(size_t)(ks * 2 + 0) * 5632 + n] = a14; ameta[(size_t)(ks * 2 + 1) * 5632 + n] = a15;
        }
        for (int row = gw; row < MR; row += 2 * NGW) {
            const int r1 = row + NGW < MR ? row + NGW : row;
            ln_row2(args.out + (size_t)row * 1024, args.out + (size_t)r1 * 1024, args.in[16], args.in[17], BA + (size_t)row * 1024, BA + (size_t)r1 * 1024, nullptr, nullptr, stats1 + 2 * row, stats1 + 2 * r1, lane);
        }
    }
    SEAM(7);

    if (IN(8)) {
        pg8::Gemm g{BA, WUP, MR, 5632, 1024}; pg8::StaticOrder S; S.init(MR, 5632, G, bx, 1 + ((DUPMASK >> 8) & 1));
        pg8::EpiUp E{args.in[19], args.in[20], ACT, HALO};
        pg8::gemm_phase<pg8::EpiUp, pg8::StaticOrder, true, true>(ldsl, g, S, E);
    }
    SEAM(8);

    if (IN(9)) REP(9) {
        const float* cw = args.in[19]; const float* cb = args.in[20];
        for (int it = gw; it < 5632; it += NGW) {
            const int idx = it * 64 + lane, ri = idx / 352, c8 = idx - ri * 352, g64 = ri >> 1, r = ri & 1;
            const int j = c8 * 8;
            const int dg = (j >> 7) * 256 + (j & 127), du = dg + 128;
            const int row = g64 * 64 + r; const int s = row & 4095;
            const bf16* hb = HALO + (size_t)g64 * 4 * 5632; const bf16* hp = hb - 4 * 5632;
            float a0g[8], a0u[8], a1g[8], a1u[8], a2g[8], a2u[8];
#define HL8(dst, p, slot, col) do { const v4u q_ = *(const v4u*)((p) + (size_t)(slot) * 5632 + (col)); dst[0] = blo(q_.x); dst[1] = bhi(q_.x); dst[2] = blo(q_.y); dst[3] = bhi(q_.y); dst[4] = blo(q_.z); dst[5] = bhi(q_.z); dst[6] = blo(q_.w); dst[7] = bhi(q_.w); } while (0)
#define AM8(dst, jr, col) do { _Pragma("unroll") for (int e_ = 0; e_ < 8; ++e_) dst[e_] = 0.f; for (int ks_ = 0; ks_ < 16; ++ks_) { const float* ap_ = ameta + (size_t)(ks_ * 2 + (jr)) * 5632 + (col); _Pragma("unroll") for (int e_ = 0; e_ < 8; ++e_) dst[e_] += ap_[e_]; } } while (0)
            HL8(a0g, hb, r, dg); HL8(a0u, hb, r, du);
            if (r == 0) {
                if (s == 0) { AM8(a1g, 1, j); AM8(a1u, 1, 2816 + j); AM8(a2g, 0, j); AM8(a2u, 0, 2816 + j); }
                else { HL8(a1g, hp, 3, dg); HL8(a1u, hp, 3, du); HL8(a2g, hp, 2, dg); HL8(a2u, hp, 2, du); }
            } else {
                HL8(a1g, hb, 0, dg); HL8(a1u, hb, 0, du);
                if (s == 1) { AM8(a2g, 1, j); AM8(a2u, 1, 2816 + j); }
                else { HL8(a2g, hp, 3, dg); HL8(a2u, hp, 3, du); }
            }
#undef HL8
#undef AM8
            float av[8];
#pragma unroll
            for (int e = 0; e < 8; ++e) {
                const float cgv = cw[j + e] * a2g[e] + cw[5632 + j + e] * a1g[e] + cw[2 * 5632 + j + e] * a0g[e] + cb[j + e];
                const float cuv = cw[2816 + j + e] * a2u[e] + cw[5632 + 2816 + j + e] * a1u[e] + cw[2 * 5632 + 2816 + j + e] * a0u[e] + cb[2816 + j + e];
                av[e] = cgv * pg8::sigm(cgv) * cuv; }
            v4u o; o.x = pk2(av[0], av[1]); o.y = pk2(av[2], av[3]); o.z = pk2(av[4], av[5]); o.w = pk2(av[6], av[7]);
            *(v4u*)(ACT + (size_t)row * 2816 + j) = o;
        }
    }
    SEAM(9);

    if (IN(10)) {
        pg8::Gemm g{ACT, WDOWN, MR, 1024, 2816}; pg8::StaticOrder S; S.init(MR, 1024, G, bx);
        pg8::EpiDown E{args.out, stats1, args.in[16], args.in[17], ALPHA};
        pg8::gemm_phase<pg8::EpiDown, pg8::StaticOrder, true, true>(ldsl, g, S, E);
    }
    SEAM(10);

    if (IN(11)) REP(11) {
        for (int row = gw; row < MR; row += 2 * NGW) {
            const int r1 = row + NGW < MR ? row + NGW : row;
            ln_row2(args.out + (size_t)row * 1024, args.out + (size_t)r1 * 1024, args.in[22], args.in[23], nullptr, nullptr, args.out + (size_t)row * 1024, args.out + (size_t)r1 * 1024, nullptr, nullptr, lane);
        }
    }
#undef IN
#undef SEAM
#undef XIN
#undef METAIN
#undef stats0
#undef stats1
#undef rope
#undef xmeta
#undef ameta
#undef WIN
#undef WPP
#undef WUQ
#undef WUKV
#undef PMLA
#undef WOUT
#undef WUP
#undef WDOWN
#undef BA
#undef GATE
#undef VP
#undef LAT
#undef DP
#undef CQN
#undef CKVN
#undef KB
#undef VB
#undef HALO
#undef ACT
#undef QB
#undef OB
}

constexpr int LDS_BYTES = 147456;
constexpr int NPHASES = 12;
#ifndef MK_SPLIT
#define MK_SPLIT 0
#endif
extern "C" void kernel_launch(void* const* d_in, const int* in_sizes, int n_in, void* d_out, int out_size, void* d_ws, size_t ws_size, hipStream_t stream) {
    static int grid = 0;
    if (grid == 0) {
        if (n_in != 24 || out_size != MR * 1024 || ws_size < WS_END) { fprintf(stderr, "kernel_launch: unexpected shapes: n_in %d out %d ws %zu\n", n_in, out_size, ws_size); grid = -1; return; }
        int dev = 0, cus = 0, per_cu = 0;
        (void)hipGetDevice(&dev); (void)hipDeviceGetAttribute(&cus, hipDeviceAttributeMultiprocessorCount, dev);
        if (hipFuncSetAttribute((const void*)mk_fwd, hipFuncAttributeMaxDynamicSharedMemorySize, LDS_BYTES) != hipSuccess) { fprintf(stderr, "kernel_launch: hipFuncSetAttribute failed\n"); grid = -1; return; }
        if (hipOccupancyMaxActiveBlocksPerMultiprocessor(&per_cu, (const void*)mk_fwd, NWAVES * 64, LDS_BYTES) != hipSuccess || per_cu < 1) { fprintf(stderr, "kernel_launch: occupancy query says %d blocks per CU\n", per_cu); (void)hipGetLastError(); per_cu = 1; }
        grid = cus * 1;
        if (grid <= 0) grid = 256;
    }
    if (grid < 0) return;
    Args a{};
    for (int i = 0; i < 24; ++i) a.in[i] = (const float*)d_in[i];
    a.out = (float*)d_out; a.ws = (unsigned char*)d_ws;
#if MK_SPLIT
    for (int p = 0; p < NPHASES; ++p) { a.ph_lo = p; a.ph_hi = p + 1; hipLaunchKernelGGL(mk_fwd, dim3(grid), dim3(NWAVES * 64), LDS_BYTES, stream, a); }
#else
    a.ph_lo = 0; a.ph_hi = NPHASES;
    void* kargs[] = {&a};
    hipError_t e = hipLaunchCooperativeKernel((const void*)mk_fwd, dim3(grid), dim3(NWAVES * 64), kargs, LDS_BYTES, stream);
    if (e != hipSuccess) fprintf(stderr, "kernel_launch: cooperative launch failed: %s (grid %d)\n", hipGetErrorString(e), grid);
#endif
}
```
